# Optimizing an MI355X kernel written in HIP

```python
import math
import jax
import jax.numpy as jnp
from jax import lax
import numpy as np

D_MODEL = 1024
BATCH = 8
SEQ = 2048
DEPTH = 4

HEAD_DIM = 64
A_HEADS = 6
A_PATTERNS = ((128, 1), (512, 4), (2048, 16))
A_WIDTH = A_HEADS * HEAD_DIM
B_HEADS = 4
B_NOPE = 64
B_ROPE = 32
B_V = 64
B_Q_RANK = 256
B_KV_RANK = 128
B_WIDTH = B_HEADS * B_V
C_HEADS = 6
C_KEY = 32
C_VAL = 64
C_WIDTH = C_HEADS * C_VAL
C_CHUNK = 128
MIX_WIDTH = A_WIDTH + B_WIDTH + C_WIDTH
IN_SIZES = (A_WIDTH, A_WIDTH, A_WIDTH, B_Q_RANK, B_KV_RANK, B_ROPE, C_HEADS * C_KEY, C_HEADS * C_KEY, C_WIDTH, C_WIDTH)
IN_WIDTH = sum(IN_SIZES)
FFN_HIDDEN = -(-8 * D_MODEL // (3 * 256)) * 256
N_BUCKETS = 32
MAX_DISTANCE = 2048
ROPE_BASE = 10000.0
EPS = 1e-6
Q_BLOCK = 128

kernel_name = 'hybrid_dilated_mla_retention_trunk'


def rmsnorm(x, g=None):
    xf = x.astype(jnp.float32)
    y = xf * lax.rsqrt(jnp.mean(xf * xf, axis=-1, keepdims=True) + EPS)
    if g is not None:
        y = y * g.astype(jnp.float32)
    return y.astype(x.dtype)


def group_norm_heads(x):
    xf = x.astype(jnp.float32)
    mu = jnp.mean(xf, axis=-1, keepdims=True)
    var = jnp.mean(jnp.square(xf - mu), axis=-1, keepdims=True)
    return ((xf - mu) * lax.rsqrt(var + EPS)).astype(x.dtype)


def rope(x, pos):
    half = x.shape[-1] // 2
    inv_freq = (1.0 / (ROPE_BASE ** (np.arange(half, dtype=np.float32) / half))).astype(np.float32)
    ang = pos[:, None, :, None].astype(jnp.float32) * inv_freq
    cos, sin = jnp.cos(ang), jnp.sin(ang)
    x1 = x[..., :half].astype(jnp.float32)
    x2 = x[..., half:].astype(jnp.float32)
    return jnp.concatenate([x1 * cos - x2 * sin, x1 * sin + x2 * cos], axis=-1).astype(x.dtype)


def t5_bucket(dist):
    max_exact = N_BUCKETS // 2
    safe = np.maximum(dist, 1).astype(np.float32)
    large = max_exact + (np.log(safe / max_exact) / np.log(MAX_DISTANCE / max_exact) * (N_BUCKETS - max_exact)).astype(np.int32)
    large = np.minimum(large, N_BUCKETS - 1)
    return np.where(dist < max_exact, dist, large).astype(np.int32)


def to_heads(t, h):
    b, s, _ = t.shape
    return t.reshape(b, s, h, -1).transpose(0, 2, 1, 3)


def from_heads(t):
    b, h, s, d = t.shape
    return t.transpose(0, 2, 1, 3).reshape(b, s, h * d)


def dilated_attention(q, k, v, rel_bias):
    b, h, s, dh = q.shape
    scale = dh ** -0.5
    patterns = []
    for (w, d) in A_PATTERNS:
        dist = np.arange(w // d + 1, dtype=np.int32) * d
        bias = jnp.transpose(rel_bias[t5_bucket(dist)]).astype(jnp.float32)
        patterns.append((jnp.asarray(dist), bias))

    def block(i):
        start = i * Q_BLOCK
        t = start + jnp.arange(Q_BLOCK, dtype=jnp.int32)
        q_blk = lax.dynamic_slice_in_dim(q, start, Q_BLOCK, axis=2).astype(jnp.float32) * scale
        ms, ls, outs = [], [], []
        for dist, bias in patterns:
            idx = t[:, None] - dist[None, :]
            valid = idx >= 0
            idx = jnp.maximum(idx, 0)
            k_g = k[:, :, idx].astype(jnp.float32)
            v_g = v[:, :, idx].astype(jnp.float32)
            sc = jnp.einsum('bhqd,bhqnd->bhqn', q_blk, k_g) + bias[None, :, None, :]
            sc = jnp.where(valid, sc, -jnp.inf)
            m = jnp.max(sc, axis=-1)
            p = jnp.exp(sc - m[..., None])
            l = jnp.sum(p, axis=-1)
            outs.append(jnp.einsum('bhqn,bhqnd->bhqd', p, v_g) / l[..., None])
            ms.append(m)
            ls.append(l)
        m_all = jnp.stack(ms)
        l_all = jnp.stack(ls)
        o_all = jnp.stack(outs)
        wts = l_all * jnp.exp(m_all - jnp.max(m_all, axis=0))
        out = jnp.sum(wts[..., None] * o_all, axis=0) / jnp.sum(wts, axis=0)[..., None]
        return out.astype(q.dtype)

    out = lax.map(block, jnp.arange(s // Q_BLOCK))
    return jnp.transpose(out, (1, 2, 0, 3, 4)).reshape(b, h, s, dh)


def mla(q_lat, kv_lat, k_rope, pos, q_norm_g, kv_norm_g, w_uq, w_ukv):
    b, s, _ = q_lat.shape
    q = to_heads(rmsnorm(q_lat, q_norm_g) @ w_uq, B_HEADS)
    q_nope = q[..., :B_NOPE]
    q_pe = rope(q[..., B_NOPE:], pos)
    kv = to_heads(rmsnorm(kv_lat, kv_norm_g) @ w_ukv, B_HEADS)
    k_nope = kv[..., :B_NOPE]
    v = kv[..., B_NOPE:]
    k_pe = rope(k_rope[:, None], pos)[:, 0]
    scale = (B_NOPE + B_ROPE) ** -0.5
    key_idx = jnp.arange(s, dtype=jnp.int32)

    def block(i):
        start = i * Q_BLOCK
        t = start + jnp.arange(Q_BLOCK, dtype=jnp.int32)
        qn = lax.dynamic_slice_in_dim(q_nope, start, Q_BLOCK, axis=2)
        qp = lax.dynamic_slice_in_dim(q_pe, start, Q_BLOCK, axis=2)
        sc = (jnp.einsum('bhqd,bhkd->bhqk', qn, k_nope) + jnp.einsum('bhqd,bkd->bhqk', qp, k_pe)).astype(jnp.float32) * scale
        sc = jnp.where(key_idx[None, :] <= t[:, None], sc, -jnp.inf)
        p = jax.nn.softmax(sc, axis=-1)
        return jnp.einsum('bhqk,bhkd->bhqd', p.astype(v.dtype), v)

    out = lax.map(block, jnp.arange(s // Q_BLOCK))
    return jnp.transpose(out, (1, 2, 0, 3, 4)).reshape(b, B_HEADS, s, B_V)


def retention(q, k, v, pos):
    b, h, s, dk = q.shape
    dv = v.shape[-1]
    n = s // C_CHUNK
    qf = rope(q, pos).astype(jnp.float32)
    kf = rope(k, pos).astype(jnp.float32) * (dk ** -0.5)
    vf = v.astype(jnp.float32)
    log_g = np.log(1.0 - 2.0 ** (-5.0 - np.arange(h))).astype(np.float32)
    i = np.arange(C_CHUNK, dtype=np.float32)
    rel = i[:, None] - i[None, :]
    decay_intra = jnp.asarray(np.exp(np.maximum(rel, 0.0)[None] * log_g[:, None, None]) * (rel >= 0)[None], dtype=jnp.float32)
    xi = jnp.asarray(np.exp((i + 1.0)[None, :] * log_g[:, None]), dtype=jnp.float32)
    zeta = jnp.asarray(np.exp((C_CHUNK - 1.0 - i)[None, :] * log_g[:, None]), dtype=jnp.float32)
    chunk_decay = jnp.asarray(np.exp(C_CHUNK * log_g), dtype=jnp.float32)

    def chunks(t):
        return t.reshape(b, h, n, C_CHUNK, t.shape[-1]).transpose(2, 0, 1, 3, 4)

    def step(state, qkv):
        qc, kc, vc = qkv
        sc = jnp.einsum('bhid,bhjd->bhij', qc, kc) * decay_intra
        o = jnp.einsum('bhij,bhjv->bhiv', sc, vc) + jnp.einsum('bhid,bhdv->bhiv', qc, state) * xi[:, :, None]
        state = state * chunk_decay[:, None, None] + jnp.einsum('bhjd,bhjv->bhdv', kc * zeta[:, :, None], vc)
        return state, o

    state0 = jnp.zeros((b, h, dk, dv), jnp.float32)
    _, o = lax.scan(step, state0, (chunks(qf), chunks(kf), chunks(vf)))
    return jnp.transpose(o, (1, 2, 0, 3, 4)).reshape(b, h, s, dv).astype(v.dtype)


def setup_inputs(seed: int = 0) -> dict:
    key = jax.random.key(seed)
    ks = jax.random.split(key, 20)

    def nrm(k, shape, sd):
        return jax.random.normal(k, shape, jnp.float32) * sd

    return {
        'x': nrm(ks[0], (BATCH, SEQ, D_MODEL), 1.0),
        'c': nrm(ks[1], (BATCH, D_MODEL), 1.0),
        'positions': jnp.arange(SEQ, dtype=jnp.int32)[None, :] + jax.random.randint(ks[2], (BATCH, 1), 0, 4096, dtype=jnp.int32),
        'rel_bias': nrm(ks[3], (N_BUCKETS, A_HEADS), 0.5),
        'ada_w': nrm(ks[4], (DEPTH, D_MODEL, 6 * D_MODEL), 0.5 * D_MODEL ** -0.5),
        'ada_b': nrm(ks[5], (DEPTH, 6 * D_MODEL), 0.02),
        'norm1_g': 1.0 + nrm(ks[6], (DEPTH, D_MODEL), 0.05),
        'w_in': nrm(ks[7], (DEPTH, D_MODEL, IN_WIDTH), D_MODEL ** -0.5),
        'mla_q_norm': 1.0 + nrm(ks[8], (DEPTH, B_Q_RANK), 0.05),
        'mla_kv_norm': 1.0 + nrm(ks[9], (DEPTH, B_KV_RANK), 0.05),
        'mla_w_uq': nrm(ks[10], (DEPTH, B_Q_RANK, B_HEADS * (B_NOPE + B_ROPE)), B_Q_RANK ** -0.5),
        'mla_w_ukv': nrm(ks[11], (DEPTH, B_KV_RANK, B_HEADS * (B_NOPE + B_V)), B_KV_RANK ** -0.5),
        'mix_gain': 1.0 + nrm(ks[12], (DEPTH, MIX_WIDTH), 0.05),
        'w_out': nrm(ks[13], (DEPTH, MIX_WIDTH, D_MODEL), MIX_WIDTH ** -0.5),
        'norm2_g': 1.0 + nrm(ks[14], (DEPTH, D_MODEL), 0.05),
        'ffn_w_gate': nrm(ks[15], (DEPTH, D_MODEL, FFN_HIDDEN), D_MODEL ** -0.5),
        'ffn_w_up': nrm(ks[16], (DEPTH, D_MODEL, FFN_HIDDEN), D_MODEL ** -0.5),
        'ffn_w_down': nrm(ks[17], (DEPTH, FFN_HIDDEN, D_MODEL), FFN_HIDDEN ** -0.5),
        'final_norm': 1.0 + nrm(ks[18], (D_MODEL,), 0.05),
    }


def reference(x, c, positions, rel_bias, ada_w, ada_b, norm1_g, w_in, mla_q_norm, mla_kv_norm, mla_w_uq, mla_w_ukv, mix_gain, w_out, norm2_g, ffn_w_gate, ffn_w_up, ffn_w_down, final_norm):
    split_at = [int(v) for v in np.cumsum(IN_SIZES)[:-1]]
    c_act = jax.nn.silu(c)
    for l in range(DEPTH):
        mod = (c_act @ ada_w[l] + ada_b[l])[:, None, :]
        sh1, sc1, g1, sh2, sc2, g2 = jnp.split(mod, 6, axis=-1)
        h = rmsnorm(x, norm1_g[l]) * (1.0 + sc1) + sh1
        proj = h @ w_in[l]
        aq, ak, av, bq_lat, bkv_lat, bk_rope, cq, ck, cv, cg = jnp.split(proj, split_at, axis=-1)
        oa = dilated_attention(to_heads(aq, A_HEADS), to_heads(ak, A_HEADS), to_heads(av, A_HEADS), rel_bias)
        ob = mla(bq_lat, bkv_lat, bk_rope, positions, mla_q_norm[l], mla_kv_norm[l], mla_w_uq[l], mla_w_ukv[l])
        oc = retention(to_heads(cq, C_HEADS), to_heads(ck, C_HEADS), to_heads(cv, C_HEADS), positions)
        mix = jnp.concatenate([
            from_heads(rmsnorm(oa)),
            from_heads(rmsnorm(ob)),
            from_heads(group_norm_heads(oc)) * jax.nn.silu(cg),
        ], axis=-1) * mix_gain[l]
        x = x + g1 * (mix @ w_out[l])
        h = rmsnorm(x, norm2_g[l]) * (1.0 + sc2) + sh2
        ffn = (jax.nn.silu(h @ ffn_w_gate[l]) * (h @ ffn_w_up[l])) @ ffn_w_down[l]
        x = x + g2 * ffn
    return rmsnorm(x, final_norm)
```

```cpp
#include <hip/hip_runtime.h>
#include <cstdio>
#include <cstdint>
#include <cmath>

#define LAS __attribute__((address_space(3)))
#define GAS __attribute__((address_space(1)))
#ifndef MK_N_LAUNCHES
#define MK_N_LAUNCHES 1
#endif

typedef unsigned short bf16;
#define FRESH_LANE() ({ int l_; asm volatile("v_mbcnt_lo_u32_b32 %0, -1, 0\n\tv_mbcnt_hi_u32_b32 %0, -1, %0" : "=v"(l_)); l_; })
typedef short bf16x8 __attribute__((ext_vector_type(8)));
typedef short s16x4 __attribute__((ext_vector_type(4)));
typedef float f32x2 __attribute__((ext_vector_type(2)));
typedef float f32x4 __attribute__((ext_vector_type(4)));
typedef float f32x16 __attribute__((ext_vector_type(16)));
typedef unsigned u32x2 __attribute__((ext_vector_type(2)));
typedef unsigned u32x4 __attribute__((ext_vector_type(4)));

constexpr int D = 1024, BATCH = 8, SEQ = 2048, DEPTH = 4, M = BATCH * SEQ;
constexpr int INW = 2720, INP = 2816, FFH = 2816, GU = 2 * FFH, UPK = 384, UPN = 1024, MODW = 6 * D;
constexpr int O_AQ = 0, O_AK = 384, O_AV = 768, O_BQ = 1152, O_BKR = 1536, O_CQ = 1568, O_CK = 1760, O_CV = 1952, O_CG = 2336;
constexpr float EPS = 1e-6f, LOG2E = 1.4426950408889634f;
constexpr float NEG_INF = -__builtin_huge_valf();

__device__ const unsigned char BUCKET[3][129] = {
 {0, 1, 2, 3, 4, 5, 6, 7, 8, 9, 10, 11, 12, 13, 14, 15, 16, 16, 16, 16, 16, 16, 17, 17, 17, 17, 17, 17, 17, 17, 18, 18, 18, 18, 18, 18, 18, 18, 18, 18, 19, 19, 19, 19, 19, 19, 19, 19, 19, 19, 19, 19, 19, 19, 20, 20, 20, 20, 20, 20, 20, 20, 20, 20, 20, 20, 20, 20, 20, 20, 20, 20, 20, 21, 21, 21, 21, 21, 21, 21, 21, 21, 21, 21, 21, 21, 21, 21, 21, 21, 21, 21, 21, 21, 21, 21, 21, 21, 21, 22, 22, 22, 22, 22, 22, 22, 22, 22, 22, 22, 22, 22, 22, 22, 22, 22, 22, 22, 22, 22, 22, 22, 22, 22, 22, 22, 22, 22, 22},
 {0, 4, 8, 12, 16, 16, 17, 17, 18, 18, 19, 19, 19, 19, 20, 20, 20, 20, 20, 21, 21, 21, 21, 21, 21, 22, 22, 22, 22, 22, 22, 22, 22, 22, 23, 23, 23, 23, 23, 23, 23, 23, 23, 23, 23, 23, 24, 24, 24, 24, 24, 24, 24, 24, 24, 24, 24, 24, 24, 24, 24, 24, 25, 25, 25, 25, 25, 25, 25, 25, 25, 25, 25, 25, 25, 25, 25, 25, 25, 25, 25, 25, 25, 26, 26, 26, 26, 26, 26, 26, 26, 26, 26, 26, 26, 26, 26, 26, 26, 26, 26, 26, 26, 26, 26, 26, 26, 26, 26, 26, 26, 26, 26, 27, 27, 27, 27, 27, 27, 27, 27, 27, 27, 27, 27, 27, 27, 27, 27},
 {0, 16, 18, 19, 20, 21, 21, 22, 22, 23, 23, 23, 24, 24, 24, 24, 25, 25, 25, 25, 25, 26, 26, 26, 26, 26, 26, 26, 26, 27, 27, 27, 27, 27, 27, 27, 27, 27, 27, 28, 28, 28, 28, 28, 28, 28, 28, 28, 28, 28, 28, 28, 29, 29, 29, 29, 29, 29, 29, 29, 29, 29, 29, 29, 29, 29, 29, 29, 29, 29, 30, 30, 30, 30, 30, 30, 30, 30, 30, 30, 30, 30, 30, 30, 30, 30, 30, 30, 30, 30, 30, 30, 30, 30, 30, 31, 31, 31, 31, 31, 31, 31, 31, 31, 31, 31, 31, 31, 31, 31, 31, 31, 31, 31, 31, 31, 31, 31, 31, 31, 31, 31, 31, 31, 31, 31, 31, 31, 31}};
__device__ const float INV_FREQ[16] = {0x1.0000000000000p+0f, 0x1.1feb340000000p-1f, 0x1.43d1360000000p-2f, 0x1.6c310e0000000p-3f, 0x1.99999a0000000p-4f, 0x1.ccab840000000p-5f, 0x1.030dc60000000p-5f, 0x1.235a720000000p-6f, 0x1.47ae140000000p-7f, 0x1.7089380000000p-8f, 0x1.9e7c700000000p-9f, 0x1.d22a500000000p-10f, 0x1.0624de0000000p-10f, 0x1.26d42c0000000p-11f, 0x1.4b96c00000000p-12f, 0x1.74eea60000000p-13f};
__device__ const float LOG_G[6] = {-0x1.0415d80000000p-5f, -0x1.0205660000000p-6f, -0x1.0101580000000p-7f, -0x1.0080560000000p-8f, -0x1.0040160000000p-9f, -0x1.0020060000000p-10f};

__device__ __forceinline__ unsigned cvtpk(float lo, float hi) { typedef __bf16 b2 __attribute__((ext_vector_type(2))); f32x2 v = {lo, hi}; b2 b = __builtin_convertvector(v, b2); return __builtin_bit_cast(unsigned, b); }
__device__ __forceinline__ float bf2f(unsigned short b) { return __uint_as_float((unsigned)b << 16); }
__device__ __forceinline__ float ex2(float x) { return __builtin_amdgcn_exp2f(x); }
__device__ __forceinline__ float silu_fast(float v) { return v * __builtin_amdgcn_rcpf(1.f + ex2(-v * LOG2E)); }
__device__ __forceinline__ float wave_sum(float v) {
#pragma unroll
    for (int o = 1; o < 64; o <<= 1) v += __shfl_xor(v, o);
    return v;
}
__device__ __forceinline__ float xmax32(float v) { auto r = __builtin_amdgcn_permlane32_swap(__float_as_uint(v), __float_as_uint(v), false, false); return fmaxf(__uint_as_float(r[0]), __uint_as_float(r[1])); }
__device__ __forceinline__ float xsum32(float v) { auto r = __builtin_amdgcn_permlane32_swap(__float_as_uint(v), __float_as_uint(v), false, false); return __uint_as_float(r[0]) + __uint_as_float(r[1]); }
__device__ __forceinline__ float xmax16(float v) { auto r = __builtin_amdgcn_permlane16_swap(__float_as_uint(v), __float_as_uint(v), false, false); return fmaxf(__uint_as_float(r[0]), __uint_as_float(r[1])); }
__device__ __forceinline__ float xsum16(float v) { auto r = __builtin_amdgcn_permlane16_swap(__float_as_uint(v), __float_as_uint(v), false, false); return __uint_as_float(r[0]) + __uint_as_float(r[1]); }
__device__ __forceinline__ int crow(int r, int hi) { return (r & 3) + 8 * (r >> 2) + 4 * hi; }
typedef short v4i16_t __attribute__((ext_vector_type(4)));
__device__ __forceinline__ s16x4 trrd(const LAS char* p) { return __builtin_bit_cast(s16x4, __builtin_amdgcn_ds_read_tr16_b64_v4i16((LAS v4i16_t*)p)); }

namespace pg8 {
typedef unsigned short bf16_t;
constexpr int BM = 256, BK = 64, HALF = 128, HTB = HALF * BK * 2, STAGE_BYTES = 8 * HTB, NXCD = 8, WGM = 8;
__host__ __device__ __forceinline__ int lds_byte(int r, int c) { const int st = (r >> 4) * 2 + (c >> 5), rr = r & 15, cc = c & 31, ob = rr * 64 + cc * 2; return st * 1024 + (ob ^ (((ob >> 9) & 1) << 5)); }
__host__ __device__ __forceinline__ void stage_rc(int b, int& R, int& C) { const int st = b / 1024, sb = b % 1024, swz = sb ^ (((sb >> 9) & 1) << 5); R = (st >> 1) * 16 + swz / 64; C = (st & 1) * 32 + (swz % 64) / 2; }
__host__ __device__ __forceinline__ int perm32(int rho) { const int n = rho >> 4, i = rho & 15; return 8 * (i >> 2) + 4 * n + (i & 3); }
struct Unit { int pm, pn; };
struct Gemm { const bf16_t* A; const bf16_t* Bt; };
template <int N_>
struct StaticOrder {
    static constexpr int nM = 64, nN = N_ / BM, nwg = nM * nN;
    int G, c;
    __host__ __device__ void init(int G_, int c_) { G = G_; c = c_; }
    __host__ __device__ bool next(int i, Unit& u) const {
        const long L = (long)i * G + c; if (L >= nwg) return false;
        int wgid = (int)L; { const int q = nwg / NXCD, r = nwg % NXCD, xcd = wgid % NXCD, off = wgid / NXCD; wgid = (xcd < r ? xcd * (q + 1) : r * (q + 1) + (xcd - r) * q) + off; }
        const int nig = WGM * nN, gid = wgid / nig, fm = gid * WGM, gsz = (nM - fm) < WGM ? (nM - fm) : WGM;
        u.pm = fm + ((wgid % nig) % gsz); u.pn = (wgid % nig) / gsz; return true;
    }
};

template <class Epi, class Sched, bool ALIGN_EPI, int K, int lda>
__device__ __forceinline__ void gemm_phase(LAS unsigned char* lds, const Gemm g, const Sched& S, const Epi& E, const int wid_in) {
    int wid = wid_in; asm volatile("" : "+s"(wid));
    const int lane = FRESH_LANE(), tid = wid * 64 + lane;
    const int wr = wid >> 2, wc = wid & 3, fr = lane & 15, fq = lane >> 4;
    constexpr int nt = K / BK;
    unsigned voffA[2], voffB[2];
#pragma unroll
    for (int i = 0; i < 2; ++i) { int R, C; stage_rc(tid * 16 + i * 8192, R, C); const int Rb = Epi::PERM ? ((R & ~31) + perm32(R & 31)) : R;
        voffA[i] = (unsigned)(R * lda + C) * 2u; voffB[i] = (unsigned)(Rb * K + C) * 2u; }
    constexpr size_t kstep = (size_t)(BK * 2);
    constexpr size_t hstepA = (size_t)HALF * lda * 2, hstepB = (size_t)HALF * K * 2;
    constexpr size_t tstepA = 2 * hstepA, tstepB = 2 * hstepB;
    const unsigned ldsw = (unsigned)wid * 1024u;
    const int aoff = lds_byte(wr * 64 + fr, fq * 8), boff = lds_byte(wc * 32 + fr, fq * 8);
#define PG8_SA(b, h) (((b) * 2 + (h)) * HTB)
#define PG8_SB(b, h) ((4 + (b) * 2 + (h)) * HTB)
#define PG8_STAGE(bufoff, gbase, voff) do { _Pragma("unroll") for (int _i = 0; _i < 2; ++_i) \
        __builtin_amdgcn_global_load_lds((const unsigned*)((const char*)(gbase) + (voff)[_i]), (LAS unsigned*)(lds + (bufoff) + ldsw + _i * 8192), 16, 0, 0); } while (0)
#define PG8_LDA(dst, b, h) do { _Pragma("unroll") for (int m = 0; m < 4; ++m) _Pragma("unroll") for (int k = 0; k < 2; ++k) dst[m][k] = *(const LAS bf16x8*)(lds + PG8_SA(b, h) + aoff + m * 2048 + k * 1024); } while (0)
#define PG8_LDB(dst, b, h) do { _Pragma("unroll") for (int n = 0; n < 2; ++n) _Pragma("unroll") for (int k = 0; k < 2; ++k) dst[n][k] = *(const LAS bf16x8*)(lds + PG8_SB(b, h) + boff + n * 2048 + k * 1024); } while (0)
#define PG8_MMA(ai, bj, At, Bt) do { __builtin_amdgcn_s_setprio(1); _Pragma("unroll") for (int m = 0; m < 4; ++m) _Pragma("unroll") for (int n = 0; n < 2; ++n) _Pragma("unroll") for (int k = 0; k < 2; ++k) \
        acc[ai][bj][m][n] = __builtin_amdgcn_mfma_f32_16x16x32_bf16(Bt[n][k], At[m][k], acc[ai][bj][m][n], 0, 0, 0); __builtin_amdgcn_s_setprio(0); } while (0)
#define PG8_WAIT_V(n) asm volatile("s_waitcnt vmcnt(" #n ")" ::: "memory")
#define PG8_WAIT_L(n) asm volatile("s_waitcnt lgkmcnt(" #n ")" ::: "memory")
#define PG8_BAR __builtin_amdgcn_s_barrier()
#define PG8_SCHED __builtin_amdgcn_sched_barrier(0)
    Unit cur, nxt; int ui = 0;
    if (!S.next(0, cur)) return;
    f32x4 acc[2][2][4][2];
#pragma unroll
    for (int a = 0; a < 2; ++a)
#pragma unroll
        for (int b = 0; b < 2; ++b)
#pragma unroll
            for (int m = 0; m < 4; ++m)
#pragma unroll
                for (int n = 0; n < 2; ++n) acc[a][b][m][n] = (f32x4){0.f, 0.f, 0.f, 0.f};
    bf16x8 At[4][2], B0[2][2], B1[2][2];
    const char* cA = (const char*)g.A + (size_t)cur.pm * tstepA; const char* cB = (const char*)g.Bt + (size_t)cur.pn * tstepB;
    PG8_STAGE(PG8_SB(0, 0), cB, voffB); PG8_STAGE(PG8_SB(0, 1), cB + hstepB, voffB); PG8_STAGE(PG8_SA(0, 0), cA, voffA); PG8_STAGE(PG8_SA(0, 1), cA + hstepA, voffA);
    if (wr == 1) PG8_BAR;
    PG8_WAIT_V(2); PG8_BAR;
    PG8_STAGE(PG8_SB(1, 0), cB + kstep, voffB); PG8_STAGE(PG8_SA(1, 0), cA + kstep, voffA); PG8_STAGE(PG8_SB(1, 1), cB + hstepB + kstep, voffB);
    PG8_WAIT_V(6); PG8_BAR;
    for (;;) {
        const bool has_next = S.next(ui + 1, nxt);
        const char* nA = has_next ? (const char*)g.A + (size_t)nxt.pm * tstepA : cA; const char* nB = has_next ? (const char*)g.Bt + (size_t)nxt.pn * tstepB : cB;
        for (int t = 0; t < nt; t += 2) {
            const bool last = (t == nt - 2);
            const char* a1 = cA + (size_t)(t + 1) * kstep;
            const char* a2 = last ? nA : cA + (size_t)(t + 2) * kstep; const char* b2 = last ? nB : cB + (size_t)(t + 2) * kstep;
            const char* a3 = a2 + kstep; const char* b3 = b2 + kstep;
            PG8_LDB(B0, 0, 0); PG8_LDB(B1, 0, 1); PG8_SCHED; PG8_LDA(At, 0, 0); PG8_STAGE(PG8_SA(1, 1), a1 + hstepA, voffA);
            PG8_WAIT_V(8); PG8_WAIT_L(0); PG8_BAR; PG8_MMA(0, 0, At, B0); PG8_MMA(0, 1, At, B1); PG8_BAR; PG8_SCHED;
            PG8_LDA(At, 0, 1); PG8_STAGE(PG8_SB(0, 0), b2, voffB); PG8_STAGE(PG8_SB(0, 1), b2 + hstepB, voffB); PG8_STAGE(PG8_SA(0, 0), a2, voffA);
            PG8_WAIT_V(8); PG8_WAIT_L(0); PG8_BAR; PG8_MMA(1, 0, At, B0); PG8_MMA(1, 1, At, B1); PG8_BAR; PG8_SCHED;
            PG8_LDB(B0, 1, 0); PG8_LDB(B1, 1, 1); PG8_SCHED; PG8_LDA(At, 1, 0); PG8_STAGE(PG8_SA(0, 1), a2 + hstepA, voffA);
            PG8_WAIT_V(8); PG8_WAIT_L(0); PG8_BAR; PG8_MMA(0, 0, At, B0); PG8_MMA(0, 1, At, B1); PG8_BAR; PG8_SCHED;
            PG8_LDA(At, 1, 1); PG8_STAGE(PG8_SB(1, 0), b3, voffB); PG8_STAGE(PG8_SB(1, 1), b3 + hstepB, voffB); PG8_STAGE(PG8_SA(1, 0), a3, voffA);
            PG8_WAIT_V(8); PG8_WAIT_L(0); PG8_BAR; PG8_MMA(1, 0, At, B0); PG8_MMA(1, 1, At, B1); PG8_BAR; PG8_SCHED;
        }
        if constexpr (ALIGN_EPI) { if (wr == 0) PG8_BAR; }
        E(acc, cur, wr, wc, fr, fq);
        if (!has_next) break;
#pragma unroll
        for (int a = 0; a < 2; ++a)
#pragma unroll
            for (int b = 0; b < 2; ++b)
#pragma unroll
                for (int m = 0; m < 4; ++m)
#pragma unroll
                    for (int n = 0; n < 2; ++n) acc[a][b][m][n] = (f32x4){0.f, 0.f, 0.f, 0.f};
        cur = nxt; cA = nA; cB = nB; ++ui;
        if constexpr (ALIGN_EPI) { if (wr == 1) PG8_BAR; }
    }
    PG8_WAIT_V(0);
    if constexpr (!ALIGN_EPI) { if (wr == 0) PG8_BAR; }
    PG8_BAR;
#undef PG8_SA
#undef PG8_SB
#undef PG8_STAGE
#undef PG8_LDA
#undef PG8_LDB
#undef PG8_MMA
#undef PG8_WAIT_V
#undef PG8_WAIT_L
#undef PG8_BAR
#undef PG8_SCHED
}

__device__ __forceinline__ void rope8(f32x4& v0, f32x4& v1, const float* ropec, const float* ropes, int row, int fq) {
    f32x4 p0, p1;
#pragma unroll
    for (int j = 0; j < 4; ++j) { p0[j] = __shfl_xor(v0[j], 32); p1[j] = __shfl_xor(v1[j], 32); }
    const float* cr = ropec + (size_t)row * 16 + 8 * (fq & 1); const float* sr = ropes + (size_t)row * 16 + 8 * (fq & 1);
    const f32x4 c0 = *(const f32x4*)cr, c1 = *(const f32x4*)(cr + 4), s0 = *(const f32x4*)sr, s1 = *(const f32x4*)(sr + 4);
    const float sg = (fq >> 1) ? 1.f : -1.f;
    v0 = v0 * c0 + p0 * s0 * sg; v1 = v1 * c1 + p1 * s1 * sg;
}
__device__ __forceinline__ void store8(bf16_t* p, f32x4 v0, f32x4 v1) { u32x4 w; w.x = cvtpk(v0[0], v0[1]); w.y = cvtpk(v0[2], v0[3]); w.z = cvtpk(v1[0], v1[1]); w.w = cvtpk(v1[2], v1[3]); *(u32x4*)p = w; }

struct EpiInProj {
    static constexpr bool PERM = true;
    bf16_t* O; float* ssp; const float* ropec; const float* ropes;
    __device__ __forceinline__ void operator()(const f32x4 (&acc)[2][2][4][2], const Unit& u, int wr, int wc, int fr, int fq) const {
        asm volatile("" : "+v"(fr), "+v"(fq));
#pragma unroll
        for (int bj = 0; bj < 2; ++bj) {
            const int g = u.pn * 8 + bj * 4 + wc;
            if (g >= 85) continue;
            const int col0 = g * 32 + 8 * fq;
#pragma unroll
            for (int ai = 0; ai < 2; ++ai)
#pragma unroll
                for (int m = 0; m < 4; ++m) {
                    const int row = u.pm * BM + ai * HALF + wr * 64 + m * 16 + fr;
                    f32x4 v0 = acc[ai][bj][m][0], v1 = acc[ai][bj][m][1];
                    if (g < 12) { v0 = v0 * (0.125f * LOG2E); v1 = v1 * (0.125f * LOG2E); }
                    else if (g >= 36 && g < 48) {
                        float ss = (v0[0] * v0[0] + v0[1] * v0[1]) + (v0[2] * v0[2] + v0[3] * v0[3]) + (v1[0] * v1[0] + v1[1] * v1[1]) + (v1[2] * v1[2] + v1[3] * v1[3]);
                        ss += __shfl_xor(ss, 16); ss += __shfl_xor(ss, 32);
                        if (fq == 0) ssp[(size_t)row * 12 + (g - 36)] = ss;
                    } else if (g >= 48 && g < 61) {
                        rope8(v0, v1, ropec, ropes, row, fq);
                        if (g >= 49) {
                            const int t = row & (SEQ - 1); const bool isk = g >= 55; const int hh = isk ? g - 55 : g - 49;
                            const float e = (float)(isk ? 1024 - t : t - 1024) * (LOG_G[hh] * LOG2E);
                            const float sc = ex2(e) * (isk ? 0.17677669529663687f : 1.f);
                            v0 = v0 * sc; v1 = v1 * sc;
                        }
                    }
                    store8(O + (size_t)row * INP + col0, v0, v1);
                    asm volatile("" ::: "memory");
                }
        }
    }
};
struct EpiUp {
    static constexpr bool PERM = true;
    bf16_t* O; const float* ssp; const float* ropec; const float* ropes;
    __device__ __forceinline__ void operator()(const f32x4 (&acc)[2][2][4][2], const Unit& u, int wr, int wc, int fr, int fq) const {
        asm volatile("" : "+v"(fr), "+v"(fq));
#pragma unroll
        for (int ai = 0; ai < 2; ++ai)
#pragma unroll
            for (int m = 0; m < 4; ++m) {
                asm volatile("" ::: "memory");
                const int row = u.pm * BM + ai * HALF + wr * 64 + m * 16 + fr;
                const f32x4 a0 = *(const f32x4*)(ssp + (size_t)row * 12), a1 = *(const f32x4*)(ssp + (size_t)row * 12 + 4), a2 = *(const f32x4*)(ssp + (size_t)row * 12 + 8);
                const float sq = ((a0[0] + a0[1]) + (a0[2] + a0[3])) + ((a1[0] + a1[1]) + (a1[2] + a1[3])), skv = (a2[0] + a2[1]) + (a2[2] + a2[3]);
                const float rq = rsqrtf(sq * (1.f / 256.f) + EPS) * (0.10206207261596575f * LOG2E), rkv = rsqrtf(skv * (1.f / 128.f) + EPS);
#pragma unroll
                for (int bj = 0; bj < 2; ++bj) {
                    const int g = u.pn * 8 + bj * 4 + wc;
                    if (g >= 28) continue;
                    f32x4 v0 = acc[ai][bj][m][0], v1 = acc[ai][bj][m][1];
                    if (g < 12) { if ((g % 3) == 2) rope8(v0, v1, ropec, ropes, row, fq); v0 = v0 * rq; v1 = v1 * rq; }
                    else { v0 = v0 * rkv; v1 = v1 * rkv; }
                    store8(O + (size_t)row * UPN + g * 32 + 8 * fq, v0, v1);
                }
            }
    }
};
struct EpiRes {
    static constexpr bool PERM = false;
    const float* res; float* out; const float* gate;
    __device__ __forceinline__ void operator()(const f32x4 (&acc)[2][2][4][2], const Unit& u, int wr, int wc, int fr, int fq) const {
        asm volatile("" : "+v"(fr), "+v"(fq));
        const int col0 = u.pn * BM + wc * 32 + 4 * fq; const float* gp = gate + (size_t)(u.pm >> 3) * MODW + col0;
        f32x4 gv[2][2];
#pragma unroll
        for (int bj = 0; bj < 2; ++bj)
#pragma unroll
            for (int n = 0; n < 2; ++n) gv[bj][n] = *(const f32x4*)(gp + bj * HALF + n * 16);
#pragma unroll
        for (int ai = 0; ai < 2; ++ai)
#pragma unroll
            for (int m = 0; m < 4; ++m) { const size_t off = (size_t)(u.pm * BM + ai * HALF + wr * 64 + m * 16 + fr) * D + col0;
#pragma unroll
                for (int bj = 0; bj < 2; ++bj)
#pragma unroll
                    for (int n = 0; n < 2; ++n) { const f32x4 r = *(const f32x4*)(res + off + bj * HALF + n * 16); *(f32x4*)(out + off + bj * HALF + n * 16) = r + gv[bj][n] * acc[ai][bj][m][n]; }
                if (m & 1) asm volatile("" ::: "memory"); }
    }
};
struct EpiSwiGLU {
    static constexpr bool PERM = true;
    bf16_t* O;
    __device__ __forceinline__ void operator()(const f32x4 (&acc)[2][2][4][2], const Unit& u, int wr, int wc, int fr, int fq) const {
        asm volatile("" : "+v"(fr), "+v"(fq));
        const int col0 = u.pn * HALF + wc * 32 + 8 * fq;
#pragma unroll
        for (int ai = 0; ai < 2; ++ai)
#pragma unroll
            for (int m = 0; m < 4; ++m) { const int row = u.pm * BM + ai * HALF + wr * 64 + m * 16 + fr;
                f32x4 v0, v1;
#pragma unroll
                for (int j = 0; j < 4; ++j) { v0[j] = silu_fast(acc[ai][0][m][0][j]) * acc[ai][1][m][0][j]; v1[j] = silu_fast(acc[ai][0][m][1][j]) * acc[ai][1][m][1][j]; }
                store8(O + (size_t)row * FFH + col0, v0, v1); }
    }
};
}

__device__ __forceinline__ int vt_chunk_off(int key, int c) { return (c >> 2) * 2048 + key * 64 + (((c & 3) ^ (((key >> 3) & 1) << 1)) << 4); }
__device__ __forceinline__ void vt_stage(LAS char* vt, const u32x4 (&vr)[4], int lane) {
#pragma unroll
    for (int e = 0; e < 4; ++e) *(LAS u32x4*)(vt + vt_chunk_off(8 * e + (lane >> 3), lane & 7)) = vr[e];
}

struct FaSrc { const bf16* q; int ldq; const bf16* k1; int ldk1; const bf16* k2; int ldk2; const bf16* v; int ldv; };
template <int NKS, int NKS1>
__device__ __forceinline__ void fa_load(bf16x8 (&kf)[NKS], u32x4 (&vr)[4], const FaSrc& S, int k0, int lane) {
    const int r = lane & 31, h = lane >> 5;
#pragma unroll
    for (int s = 0; s < NKS; ++s) {
        const bf16* p = (s < NKS1) ? S.k1 + (size_t)(k0 + r) * S.ldk1 + 16 * s + 8 * h : S.k2 + (size_t)(k0 + r) * S.ldk2 + 16 * (s - NKS1) + 8 * h;
        kf[s] = *(const bf16x8*)p; }
#pragma unroll
    for (int e = 0; e < 4; ++e) vr[e] = *(const u32x4*)(S.v + (size_t)(k0 + 8 * e + (lane >> 3)) * S.ldv + 8 * (lane & 7));
}
template <int NKS, bool SOFTMAX>
__device__ __forceinline__ void fa_tile(const bf16x8 (&kf)[NKS], const u32x4 (&vr)[4], const bf16x8 (&qf)[NKS], f32x16 (&O)[2], float& m, float& l, LAS char* vt, int k0, int q0, bool diag, int lane) {
    const int r = lane & 31, h = lane >> 5;
    vt_stage(vt, vr, lane);
    f32x16 S;
#pragma unroll
    for (int i = 0; i < 16; ++i) S[i] = 0.f;
#pragma unroll
    for (int s = 0; s < NKS; ++s) S = __builtin_amdgcn_mfma_f32_32x32x16_bf16(kf[s], qf[s], S, 0, 0, 0);
    if (diag) {
#pragma unroll
        for (int i = 0; i < 16; ++i) if (k0 + crow(i, h) > q0 + r) S[i] = SOFTMAX ? NEG_INF : 0.f;
    }
    if (SOFTMAX) {
        float mx = S[0];
#pragma unroll
        for (int i = 1; i < 16; ++i) mx = fmaxf(mx, S[i]);
        mx = xmax32(mx);
        const float mn = fmaxf(m, mx), ms = (mn == NEG_INF) ? 0.f : mn, alpha = ex2(m - ms);
        m = mn; l *= alpha;
#pragma unroll
        for (int i = 0; i < 16; ++i) { O[0][i] *= alpha; O[1][i] *= alpha; }
        float sum = 0.f;
#pragma unroll
        for (int i = 0; i < 16; ++i) { S[i] = ex2(S[i] - ms); sum += S[i]; }
        l += sum;
    }
    bf16x8 pf[2];
#pragma unroll
    for (int s2 = 0; s2 < 2; ++s2) { u32x4 w; w.x = cvtpk(S[8 * s2 + 0], S[8 * s2 + 1]); w.y = cvtpk(S[8 * s2 + 2], S[8 * s2 + 3]); w.z = cvtpk(S[8 * s2 + 4], S[8 * s2 + 5]); w.w = cvtpk(S[8 * s2 + 6], S[8 * s2 + 7]); pf[s2] = __builtin_bit_cast(bf16x8, w); }
    const int g16 = (lane >> 4) & 1, q = (lane & 15) >> 2, p = lane & 3;
    const int ch = 2 * g16 + (p >> 1);
    const LAS char* blo = vt + (4 * h + q) * 64 + (ch << 4) + (p & 1) * 8;
    const LAS char* bhi = vt + (8 + 4 * h + q) * 64 + ((ch ^ 2) << 4) + (p & 1) * 8;
#pragma unroll
    for (int vb = 0; vb < 2; ++vb)
#pragma unroll
        for (int s2 = 0; s2 < 2; ++s2) {
            const s16x4 lo = trrd(blo + vb * 2048 + s2 * 1024), hi = trrd(bhi + vb * 2048 + s2 * 1024);
            const bf16x8 vf = {lo[0], lo[1], lo[2], lo[3], hi[0], hi[1], hi[2], hi[3]};
            O[vb] = __builtin_amdgcn_mfma_f32_32x32x16_bf16(vf, pf[s2], O[vb], 0, 0, 0);
        }
}
template <int NKS, int NKS1, int MODE>
__device__ __forceinline__ void fa_unit(const FaSrc& S, int q0, LAS char* vt, bf16* mixrow0  , const float* gain, const bf16* gate  , int lane) {
    const int r = lane & 31, h = lane >> 5;
    bf16x8 qf[NKS];
#pragma unroll
    for (int s = 0; s < NKS; ++s) qf[s] = *(const bf16x8*)(S.q + (size_t)(q0 + r) * S.ldq + 16 * s + 8 * h);
    f32x16 O[2];
#pragma unroll
    for (int i = 0; i < 16; ++i) { O[0][i] = 0.f; O[1][i] = 0.f; }
    float m = NEG_INF, l = 0.f;
    const int nt = q0 / 32 + 1;
    bf16x8 kfA[NKS], kfB[NKS]; u32x4 vrA[4], vrB[4];
    fa_load<NKS, NKS1>(kfA, vrA, S, 0, lane);
    for (int kt = 0; kt < nt; kt += 2) {
        fa_load<NKS, NKS1>(kfB, vrB, S, (kt + 1 < nt ? kt + 1 : nt - 1) * 32, lane);
        fa_tile<NKS, MODE == 0>(kfA, vrA, qf, O, m, l, vt, kt * 32, q0, kt == nt - 1, lane);
        fa_load<NKS, NKS1>(kfA, vrA, S, (kt + 2 < nt ? kt + 2 : nt - 1) * 32, lane);
        if (kt + 1 < nt) fa_tile<NKS, MODE == 0>(kfB, vrB, qf, O, m, l, vt, (kt + 1) * 32, q0, kt + 1 == nt - 1, lane);
    }
    const size_t tok = (size_t)(q0 + r);
    if (MODE == 0) {
        const float lt = xsum32(l), inv = 1.f / lt;
        float ss = 0.f;
#pragma unroll
        for (int vb = 0; vb < 2; ++vb)
#pragma unroll
            for (int i = 0; i < 16; ++i) { O[vb][i] *= inv; ss += O[vb][i] * O[vb][i]; }
        ss = xsum32(ss);
        const float rs = rsqrtf(ss * (1.f / 64.f) + EPS);
#pragma unroll
        for (int vb = 0; vb < 2; ++vb)
#pragma unroll
            for (int g = 0; g < 4; ++g) { const int d0 = 32 * vb + 8 * g + 4 * h; const f32x4 gn = *(const f32x4*)(gain + d0);
                u32x2 w; w.x = cvtpk(O[vb][4 * g] * rs * gn[0], O[vb][4 * g + 1] * rs * gn[1]); w.y = cvtpk(O[vb][4 * g + 2] * rs * gn[2], O[vb][4 * g + 3] * rs * gn[3]);
                *(u32x2*)(mixrow0 + tok * D + d0) = w; }
    } else {
        float su = 0.f;
#pragma unroll
        for (int vb = 0; vb < 2; ++vb)
#pragma unroll
            for (int i = 0; i < 16; ++i) su += O[vb][i];
        su = xsum32(su);
        const float mu = su * (1.f / 64.f); float var = 0.f;
#pragma unroll
        for (int vb = 0; vb < 2; ++vb)
#pragma unroll
            for (int i = 0; i < 16; ++i) { O[vb][i] -= mu; var += O[vb][i] * O[vb][i]; }
        var = xsum32(var);
        const float rs = rsqrtf(var * (1.f / 64.f) + EPS);
#pragma unroll
        for (int vb = 0; vb < 2; ++vb)
#pragma unroll
            for (int g = 0; g < 4; ++g) { const int d0 = 32 * vb + 8 * g + 4 * h; const f32x4 gn = *(const f32x4*)(gain + d0);
                const u32x2 gb = *(const u32x2*)(gate + tok * INP + d0);
                const float g0 = silu_fast(__uint_as_float(gb.x << 16)), g1 = silu_fast(__uint_as_float(gb.x & 0xffff0000u)), g2 = silu_fast(__uint_as_float(gb.y << 16)), g3 = silu_fast(__uint_as_float(gb.y & 0xffff0000u));
                u32x2 w; w.x = cvtpk(O[vb][4 * g] * rs * gn[0] * g0, O[vb][4 * g + 1] * rs * gn[1] * g1); w.y = cvtpk(O[vb][4 * g + 2] * rs * gn[2] * g2, O[vb][4 * g + 3] * rs * gn[3] * g3);
                *(u32x2*)(mixrow0 + tok * D + d0) = w; }
    }
}

__device__ __forceinline__ void dil_params(int si, int n3, int n2, int s2s, int s1s, int T0, int r, int& kb, int& sh, int& p) {
    if (si < n3) { p = 2; sh = 4; kb = 512 * si + r; }
    else if (si < n3 + n2) { const int s = s2s + (si - n3); p = 1; sh = 2; kb = 4 * ((T0 >> 2) + (r >> 2) - 128 + 32 * s) + (r & 3); }
    else { const int s = s1s + (si - n3 - n2); p = 0; sh = 0; kb = T0 - 128 + 32 * s; }
}
__device__ __forceinline__ int clampi(int v, int lo, int hi) { return v < lo ? lo : (v > hi ? hi : v); }
__device__ __forceinline__ void dil_load(bf16x8 (&kf)[2][2], u32x4 (&vr)[4], const bf16* P, int h, int kb, int sh, int lane) {
    const int mrow = lane & 15, q4 = lane >> 4;
#pragma unroll
    for (int a = 0; a < 2; ++a) { const int kk = 8 * (mrow >> 2) + 4 * a + (mrow & 3); const int tk = clampi(kb + (kk << sh), 0, SEQ - 1);
        const bf16* p = P + (size_t)tk * INP + O_AK + h * 64 + 8 * q4;
        kf[a][0] = *(const bf16x8*)p; kf[a][1] = *(const bf16x8*)(p + 32); }
#pragma unroll
    for (int e = 0; e < 4; ++e) { const int kk = 8 * e + (lane >> 3); const int tk = clampi(kb + (kk << sh), 0, SEQ - 1);
        vr[e] = *(const u32x4*)(P + (size_t)tk * INP + O_AV + h * 64 + 8 * (lane & 7)); }
}
__device__ __forceinline__ void dil_step(const bf16x8 (&kf)[2][2], const u32x4 (&vr)[4], bf16x8 qf0, bf16x8 qf1, f32x4 (&O)[4], float& m, float& l, LAS char* vt, const LAS float* tabh, int kb, int sh, int p, int tq, int lane) {
    const int q4 = lane >> 4;
    vt_stage(vt, vr, lane);
    f32x4 S[2];
#pragma unroll
    for (int a = 0; a < 2; ++a) { S[a] = (f32x4){0.f, 0.f, 0.f, 0.f};
        S[a] = __builtin_amdgcn_mfma_f32_16x16x32_bf16(kf[a][0], qf0, S[a], 0, 0, 0);
        S[a] = __builtin_amdgcn_mfma_f32_16x16x32_bf16(kf[a][1], qf1, S[a], 0, 0, 0); }
    const int jq = (tq - kb) >> sh;
    float sc[8];
#pragma unroll
    for (int a = 0; a < 2; ++a)
#pragma unroll
        for (int i = 0; i < 4; ++i) { const int kk = 8 * q4 + 4 * a + i, jidx = jq - kk;
            const bool valid = ((unsigned)jidx <= 128u) && (kb + (kk << sh) >= 0);
            const float b = tabh[p * 132 + clampi(jidx, 0, 128)];
            sc[4 * a + i] = (S[a][i] + b) + (valid ? 0.f : NEG_INF); }
    float mx = sc[0];
#pragma unroll
    for (int i = 1; i < 8; ++i) mx = fmaxf(mx, sc[i]);
    mx = xmax32(xmax16(mx));
    const float mn = fmaxf(m, mx), ms = (mn == NEG_INF) ? 0.f : mn, alpha = ex2(m - ms);
    m = mn; l *= alpha;
#pragma unroll
    for (int db = 0; db < 4; ++db) O[db] = O[db] * alpha;
    float sum = 0.f;
#pragma unroll
    for (int i = 0; i < 8; ++i) { sc[i] = ex2(sc[i] - ms); sum += sc[i]; }
    l += sum;
    u32x4 w; w.x = cvtpk(sc[0], sc[1]); w.y = cvtpk(sc[2], sc[3]); w.z = cvtpk(sc[4], sc[5]); w.w = cvtpk(sc[6], sc[7]);
    const bf16x8 pf = __builtin_bit_cast(bf16x8, w);
    const int q = (lane & 15) >> 2, pp = lane & 3, sw = (q4 & 1) << 1;
    const LAS char* base = vt + (8 * q4 + q) * 64 + (pp & 1) * 8;
#pragma unroll
    for (int db = 0; db < 4; ++db) {
        const int ch = 2 * (db & 1) + (pp >> 1);
        const LAS char* pa = base + (db >> 1) * 2048 + ((ch ^ sw) << 4);
        const s16x4 lo = trrd(pa), hi = trrd(pa + 4 * 64);
        const bf16x8 vf = {lo[0], lo[1], lo[2], lo[3], hi[0], hi[1], hi[2], hi[3]};
        O[db] = __builtin_amdgcn_mfma_f32_16x16x32_bf16(vf, pf, O[db], 0, 0, 0);
    }
}
__device__ __forceinline__ void dil_unit(const bf16* P, bf16* MX, int h, int T0, int r, LAS char* vt, const LAS float* tabh, const float* gain, int lane) {
    const int n = lane & 15, q4 = lane >> 4, tq = T0 + 16 * n + r;
    const bf16* qp = P + (size_t)tq * INP + O_AQ + h * 64 + 8 * q4;
    const bf16x8 qf0 = *(const bf16x8*)qp, qf1 = *(const bf16x8*)(qp + 32);
    f32x4 O[4];
#pragma unroll
    for (int db = 0; db < 4; ++db) O[db] = (f32x4){0.f, 0.f, 0.f, 0.f};
    float m = NEG_INF, l = 0.f;
    const int n3 = (T0 >> 9) + 1, s2s = (T0 == 0) ? 3 : ((T0 == 256) ? 1 : 0), n2 = 6 - s2s, s1s = (T0 == 0) ? 4 : 0, ns = n3 + n2 + 12 - s1s;
    bf16x8 kfA[2][2], kfB[2][2]; u32x4 vrA[4], vrB[4];
    int kbA, shA, pA, kbB = 0, shB = 0, pB = 0;
    dil_params(0, n3, n2, s2s, s1s, T0, r, kbA, shA, pA); dil_load(kfA, vrA, P, h, kbA, shA, lane);
    for (int si = 0; si < ns; si += 2) {
        dil_params(si + 1 < ns ? si + 1 : ns - 1, n3, n2, s2s, s1s, T0, r, kbB, shB, pB); dil_load(kfB, vrB, P, h, kbB, shB, lane);
        dil_step(kfA, vrA, qf0, qf1, O, m, l, vt, tabh, kbA, shA, pA, tq, lane);
        dil_params(si + 2 < ns ? si + 2 : ns - 1, n3, n2, s2s, s1s, T0, r, kbA, shA, pA); dil_load(kfA, vrA, P, h, kbA, shA, lane);
        if (si + 1 < ns) dil_step(kfB, vrB, qf0, qf1, O, m, l, vt, tabh, kbB, shB, pB, tq, lane);
    }
    const float lt = xsum32(xsum16(l));
    const float inv = 1.f / lt; float ss = 0.f;
#pragma unroll
    for (int db = 0; db < 4; ++db) { O[db] = O[db] * inv; ss += (O[db][0] * O[db][0] + O[db][1] * O[db][1]) + (O[db][2] * O[db][2] + O[db][3] * O[db][3]); }
    ss = xsum32(xsum16(ss));
    const float rs = rsqrtf(ss * (1.f / 64.f) + EPS);
#pragma unroll
    for (int db = 0; db < 4; ++db) { const int d0 = 16 * db + 4 * q4; const f32x4 gn = *(const f32x4*)(gain + d0);
        u32x2 w; w.x = cvtpk(O[db][0] * rs * gn[0], O[db][1] * rs * gn[1]); w.y = cvtpk(O[db][2] * rs * gn[2], O[db][3] * rs * gn[3]);
        *(u32x2*)(MX + (size_t)tq * D + h * 64 + d0) = w; }
}

constexpr size_t MiB = 1u << 20;
constexpr size_t WS_CTL = 0, CTL_ZERO_BYTES = 1 * MiB;
constexpr size_t WS_MOD = 1 * MiB, WS_MODP = 2 * MiB, WS_ROPE = 9 * MiB, WS_SSP = 11 * MiB;
constexpr size_t WS_WIN = 12 * MiB, WS_WOUT = 34 * MiB, WS_WGU = 42 * MiB, WS_WDN = 86 * MiB, WS_WUP = 108 * MiB;
constexpr size_t WS_XN = 112 * MiB, WS_MIX = 144 * MiB, WS_UPO = 176 * MiB, WS_PROJ = 208 * MiB, WS_END = 296 * MiB;
constexpr int CW_BAR = 4096;
constexpr int RING_BYTES = 131072, LDSCTL_OFF = RING_BYTES, MISC_OFF = LDSCTL_OFF + 320, PTAB_OFF = LDSCTL_OFF + 512, TAB_OFF = LDSCTL_OFF + 768, LDS_BYTES = TAB_OFF + 6 * 3 * 132 * 4 + 64;
static_assert(LDS_BYTES <= 160 * 1024, "LDS");
constexpr int NWAVES = 8;
constexpr int NSTEPS = 3 + 8 * DEPTH;

#define XB_TMO      128
#define XB_XCNT(j)  (256  + 64 * (j))
#define XB_XSUB(j)  (1280 + 64 * (j))
#define XB_XGEN(j)  (2304 + 64 * (j))
#define XB_TOP      3328
#define XB_TOPGEN   3392
#define XCD_BAR_WORDS 3456
#define XB_SPIN_CAP (1u << 18)
typedef GAS unsigned gu32;
__device__ __forceinline__ unsigned xb_ld(gu32* p)              { return __hip_atomic_load(p, __ATOMIC_RELAXED, __HIP_MEMORY_SCOPE_AGENT); }
__device__ __forceinline__ unsigned xb_add(gu32* p, unsigned v) { return __hip_atomic_fetch_add(p, v, __ATOMIC_RELAXED, __HIP_MEMORY_SCOPE_AGENT); }
__device__ __forceinline__ unsigned xb_xcc_id() { return (unsigned)__builtin_amdgcn_s_getreg((3 << 11) | 20) & 0xFu; }
#define XB_SPIN(cond, bar) do { unsigned _sp = 0; while (cond) { __builtin_amdgcn_s_sleep(1); \
    if ((++_sp & 255u) == 0u) { if (xb_ld(&(bar)[XB_TMO])) break; if (_sp > XB_SPIN_CAP) { xb_add(&(bar)[XB_TMO], 1u); break; } } } } while (0)
struct XcdBarrier { unsigned x; volatile LAS unsigned* st; };
__device__ __forceinline__ XcdBarrier xcd_barrier_post(gu32* bar, volatile LAS unsigned* st, bool t0) {
    XcdBarrier b; b.x = xb_xcc_id(); b.st = st;
    if (t0) (void)xb_add(&bar[XB_XCNT(b.x)], 1u);
    return b;
}
__device__ __forceinline__ void xcd_barrier_complete(gu32* bar, unsigned x, unsigned& nloc, unsigned& nx) {
    const unsigned G = gridDim.x * gridDim.y * gridDim.z;
    unsigned sum, cnt, mine, sp = 0u;
    for (;;) {
        sum = 0u; cnt = 0u; mine = 0u;
#pragma unroll
        for (unsigned j = 0; j < 16; ++j) { const unsigned c = xb_ld(&bar[XB_XCNT(j)]); sum += c; cnt += (c > 0u) ? 1u : 0u; mine = (j == x) ? c : mine; }
        if (sum == G) break;
        __builtin_amdgcn_s_sleep(1);
        if ((++sp & 255u) == 0u) { if (xb_ld(&bar[XB_TMO])) break; if (sp > XB_SPIN_CAP) { xb_add(&bar[XB_TMO], 1u); break; } }
    }
    nloc = mine > 0u ? mine : 1u; nx = cnt > 0u ? cnt : 1u;
}
__device__ __forceinline__ void xcd_barrier(const XcdBarrier& b, gu32* bar_, int wave) {
    asm volatile("s_waitcnt vmcnt(0)" ::: "memory");
    __syncthreads();
    if (wave == 0 && FRESH_LANE() == 0) {
        unsigned long long bv_ = (unsigned long long)bar_; asm volatile("" : "+v"(bv_)); gu32* bar = (gu32*)bv_;
        __builtin_amdgcn_s_waitcnt(0);
        unsigned nloc = b.st[0], nx = b.st[1];
        if (nloc == 0u) { xcd_barrier_complete(bar, b.x, nloc, nx); b.st[0] = nloc; b.st[1] = nx; }
        const unsigned old = xb_add(&bar[XB_XSUB(b.x)], 1u);
        const unsigned gen = old / nloc;
        if (old + 1u == (gen + 1u) * nloc) {
            __builtin_amdgcn_fence(__ATOMIC_RELEASE, "agent");
            asm volatile("s_waitcnt vmcnt(0)" ::: "memory");
            const unsigned og = xb_add(&bar[XB_TOP], 1u);
            const unsigned tg = og / nx;
            if (og + 1u == (tg + 1u) * nx) xb_add(&bar[XB_TOPGEN], 1u);
            else XB_SPIN(xb_ld(&bar[XB_TOPGEN]) == tg, bar);
            __builtin_amdgcn_fence(__ATOMIC_ACQUIRE, "agent");
            xb_add(&bar[XB_XGEN(b.x)], 1u);
            asm volatile("s_waitcnt vmcnt(0)" ::: "memory");
        } else {
            XB_SPIN(xb_ld(&bar[XB_XGEN(b.x)]) == gen, bar);
            __builtin_amdgcn_fence(__ATOMIC_ACQUIRE, "agent");
            asm volatile("s_waitcnt vmcnt(0)" ::: "memory");
        }
    }
    __syncthreads();
}

__device__ __forceinline__ void transpose_item(const float* W, int K, int N, bf16* WT, int k0, int n0, int orow0, LAS float* scr, int lane) {
#pragma unroll 8
    for (int i = 0; i < 32; ++i) { const int kk = 2 * i + (lane >> 5); scr[kk * 33 + (lane & 31)] = W[(size_t)(k0 + kk) * N + n0 + (lane & 31)]; }
    asm volatile("s_waitcnt lgkmcnt(0)" ::: "memory");
    const int c = lane & 7;
#pragma unroll
    for (int j = 0; j < 4; ++j) { const int n = (lane >> 3) + 8 * j; const LAS float* s = scr + (8 * c) * 33 + n;
        u32x4 o; o.x = cvtpk(s[0 * 33], s[1 * 33]); o.y = cvtpk(s[2 * 33], s[3 * 33]); o.z = cvtpk(s[4 * 33], s[5 * 33]); o.w = cvtpk(s[6 * 33], s[7 * 33]);
        *(u32x4*)(WT + (size_t)(orow0 + n) * K + k0 + 8 * c) = o; }
    asm volatile("s_waitcnt lgkmcnt(0)" ::: "memory");
}
__device__ __forceinline__ void ln_rows(int gw, int ngw, int lane, const float* xin, const float* g, const float* modl, int ch_sh, int ch_sc, bf16* xn, float* outf) {
    for (int m = gw; m < M; m += ngw) {
        const f32x4* xr = (const f32x4*)(xin + (size_t)m * D) + lane;
        f32x4 v[4]; float s = 0.f;
#pragma unroll
        for (int j = 0; j < 4; ++j) { v[j] = xr[64 * j]; s += (v[j][0] * v[j][0] + v[j][1] * v[j][1]) + (v[j][2] * v[j][2] + v[j][3] * v[j][3]); }
        const float rs = rsqrtf(wave_sum(s) * (1.f / D) + EPS);
        const int b = m / SEQ;
#pragma unroll
        for (int j = 0; j < 4; ++j) { const int n0 = 4 * lane + 256 * j; f32x4 y = v[j] * rs * *(const f32x4*)(g + n0);
            if (modl) { const f32x4 sc = *(const f32x4*)(modl + (size_t)b * MODW + ch_sc * D + n0), sh = *(const f32x4*)(modl + (size_t)b * MODW + ch_sh * D + n0); y = y * (sc + 1.f) + sh; }
            if (xn) { u32x2 w; w.x = cvtpk(y[0], y[1]); w.y = cvtpk(y[2], y[3]); *(u32x2*)(xn + (size_t)m * D + n0) = w; }
            else *(f32x4*)(outf + (size_t)m * D + n0) = y; }
    }
}

struct Args { const float* in[19]; float* out; unsigned char* ws; int st_lo, st_hi; };
__global__ void __launch_bounds__(NWAVES * 64, 2) fwd(Args args) {
    extern __shared__ __attribute__((aligned(16))) unsigned char lds_raw[];
    LAS unsigned char* lds = (LAS unsigned char*)lds_raw;
    volatile LAS unsigned* MISC = (volatile LAS unsigned*)(lds + MISC_OFF);
    const int wave = __builtin_amdgcn_readfirstlane(threadIdx.x >> 6);
    const int G = gridDim.x; const int bx = blockIdx.x; const int vcu = (G % 8 == 0) ? (bx % 8) * (G / 8) + bx / 8 : bx;
    const int gw = vcu * NWAVES + wave, ngw = G * NWAVES, ngt = ngw * 64;
    LAS unsigned long long* ptab = (LAS unsigned long long*)(lds + PTAB_OFF);
    const int tid = wave * 64 + FRESH_LANE();
    if (tid == 0) {
#pragma unroll
        for (int i = 0; i < 19; ++i) ptab[i] = (unsigned long long)args.in[i];
        ptab[19] = (unsigned long long)args.out; ptab[20] = (unsigned long long)args.ws;
    }
#define FRESH_TID() (wave * 64 + FRESH_LANE())
#define FRESH_S(x) ({ int s_ = (x); asm volatile("" : "+s"(s_)); s_; })
#define LDP_RAW(i) ({ const unsigned long long v_ = ptab[i]; const unsigned lo_ = __builtin_amdgcn_readfirstlane((unsigned)v_), hi_ = __builtin_amdgcn_readfirstlane((unsigned)(v_ >> 32)); ((unsigned long long)hi_ << 32) | lo_; })
#define LDF(i) ((const float*)(const GAS float*)LDP_RAW(i))
#define LDWS(off) ((unsigned char*)(GAS unsigned char*)(LDP_RAW(20) + (off)))
#define LDOUT() ((float*)(GAS float*)LDP_RAW(19))
    for (int u = tid; u < (PTAB_OFF - LDSCTL_OFF) / 4; u += NWAVES * 64) ((LAS unsigned*)(lds + LDSCTL_OFF))[u] = 0u;
    LAS float* tab = (LAS float*)(lds + TAB_OFF);
    { const float* rel_bias = args.in[3];
      for (int u = tid; u < 6 * 3 * 129; u += NWAVES * 64) { const int j = u % 129, hp = u / 129, p = hp % 3, h = hp / 3; tab[hp * 132 + j] = rel_bias[BUCKET[p][j] * 6 + h] * LOG2E; } }
    __syncthreads();
    const int lo = args.st_lo, hi = args.st_hi;
    const XcdBarrier bar = xcd_barrier_post((gu32*)(args.ws + WS_CTL) + CW_BAR, MISC + 8, tid == 0);
#ifndef PHASE_MASK
#define PHASE_MASK 0xffff
#endif
#ifndef DUP_RET
#define DUP_RET 1
#endif
#ifndef DUP_DIL
#define DUP_DIL 1
#endif
#ifndef DUP_MLA
#define DUP_MLA 1
#endif
#ifndef DUP_INPROJ
#define DUP_INPROJ 1
#endif
#ifndef DUP_GU
#define DUP_GU 1
#endif
#ifndef DUP_LN2
#define DUP_LN2 1
#endif
#define PHM(b) ((PHASE_MASK >> (b)) & 1)
#define IN(k) (lo <= (k) && (k) < hi)
#define SEAM(k) do { if (IN(k) && IN((k) + 1)) xcd_barrier(bar, (gu32*)(args.ws + WS_CTL) + CW_BAR, wave); } while (0)

    if (PHM(0) && IN(0)) {
        const int tidp = FRESH_TID(), lane = tidp & 63, gt = gw * 64 + lane;
        const float* c_in = LDF(1); const int* pos = (const int*)LDF(2); const float* ada_w = LDF(4); const float* w_in = LDF(7);
        const float* q_norm = LDF(8); const float* kv_norm = LDF(9); const float* w_uq = LDF(10); const float* w_ukv = LDF(11);
        const float* w_out = LDF(13); const float* w_gate = LDF(15); const float* w_up = LDF(16); const float* w_down = LDF(17);
        float* modp = (float*)LDWS(WS_MODP); float* ropec = (float*)LDWS(WS_ROPE); float* ropes = ropec + (size_t)M * 16;
        bf16* Win_t = (bf16*)LDWS(WS_WIN); bf16* Wout_t = (bf16*)LDWS(WS_WOUT); bf16* Wgu_t = (bf16*)LDWS(WS_WGU); bf16* Wdn_t = (bf16*)LDWS(WS_WDN); bf16* Wup_t = (bf16*)LDWS(WS_WUP);
        LAS float* scr = (LAS float*)(lds + wave * 8704);
        LAS float* cact = (LAS float*)(lds + 73728);
        for (int i = tidp; i < BATCH * D; i += NWAVES * 64) { const int b = i / D, k = i % D; const float v = c_in[i]; cact[k * 8 + b] = v / (1.f + expf(-v)); }
        __syncthreads();
        for (int it = gw; it < DEPTH * 96 * 8; it += ngw) {
            const int kq = it & 7, cg = (it >> 3) % 96, l = it / (96 * 8), n = cg * 64 + lane;
            const float* wp = ada_w + ((size_t)l * D + kq * 128) * MODW + n;
            float a[8];
#pragma unroll
            for (int b = 0; b < 8; ++b) a[b] = 0.f;
#pragma unroll 16
            for (int k = 0; k < 128; ++k) { const float wv = wp[(size_t)k * MODW]; const f32x4 c0 = *(const LAS f32x4*)(cact + (kq * 128 + k) * 8), c1 = *(const LAS f32x4*)(cact + (kq * 128 + k) * 8 + 4);
                a[0] += c0[0] * wv; a[1] += c0[1] * wv; a[2] += c0[2] * wv; a[3] += c0[3] * wv; a[4] += c1[0] * wv; a[5] += c1[1] * wv; a[6] += c1[2] * wv; a[7] += c1[3] * wv; }
#pragma unroll
            for (int b = 0; b < 8; ++b) modp[(((size_t)kq * DEPTH + l) * BATCH + b) * MODW + n] = a[b];
        }
        constexpr int I_IN = 16 * 85, I_OUT = 16 * 32, I_G = 16 * 88, I_DN = 44 * 32, I_L = I_IN + I_OUT + 2 * I_G + I_DN;
        for (int it = gw; it < DEPTH * I_L; it += ngw) {
            const int l = it / I_L; int r = it % I_L;
            if (r < I_IN) { const int kb = r / 85, nb = r % 85; transpose_item(w_in + (size_t)l * D * INW, D, INW, Win_t + (size_t)l * INP * D, 64 * kb, 32 * nb, 32 * nb, scr, lane); continue; } r -= I_IN;
            if (r < I_OUT) { const int kb = r / 32, nb = r % 32; transpose_item(w_out + (size_t)l * D * D, D, D, Wout_t + (size_t)l * D * D, 64 * kb, 32 * nb, 32 * nb, scr, lane); continue; } r -= I_OUT;
            if (r < I_G) { const int kb = r / 88, nb = r % 88, n0 = 32 * nb; transpose_item(w_gate + (size_t)l * D * FFH, D, FFH, Wgu_t + (size_t)l * GU * D, 64 * kb, n0, 256 * (n0 >> 7) + (n0 & 127), scr, lane); continue; } r -= I_G;
            if (r < I_G) { const int kb = r / 88, nb = r % 88, n0 = 32 * nb; transpose_item(w_up + (size_t)l * D * FFH, D, FFH, Wgu_t + (size_t)l * GU * D, 64 * kb, n0, 256 * (n0 >> 7) + 128 + (n0 & 127), scr, lane); continue; } r -= I_G;
            { const int kb = r / 32, nb = r % 32; transpose_item(w_down + (size_t)l * FFH * D, FFH, D, Wdn_t + (size_t)l * D * FFH, 64 * kb, 32 * nb, 32 * nb, scr, lane); }
        }
        for (int i = gt; i < DEPTH * 96 * D / 8; i += ngt) { const int l = i / (96 * D / 8), r = i % (96 * D / 8); *(u32x4*)(Win_t + (size_t)l * INP * D + (size_t)INW * D + (size_t)r * 8) = (u32x4){0u, 0u, 0u, 0u}; }
        for (int i = gt; i < DEPTH * UPN * UPK; i += ngt) { const int l = i / (UPN * UPK), rr = i % (UPN * UPK), n = rr / UPK, k = rr % UPK; float v = 0.f;
            if (n < 384) { if (k < 256) v = q_norm[l * 256 + k] * w_uq[((size_t)l * 256 + k) * 384 + n]; }
            else if (n < 896) { if (k >= 256) v = kv_norm[l * 128 + (k - 256)] * w_ukv[((size_t)l * 128 + (k - 256)) * 512 + (n - 384)]; }
            Wup_t[i] = (bf16)(cvtpk(v, 0.f) & 0xffffu); }
        for (int i = gt; i < M * 16; i += ngt) { const int m = i >> 4, f = i & 15; const float ang = (float)pos[m] * INV_FREQ[f]; ropec[i] = cosf(ang); ropes[i] = sinf(ang); }
    }
    SEAM(0);
    if (PHM(1) && IN(1)) {
        const int gt = gw * 64 + (FRESH_TID() & 63);
        const float* ada_b = LDF(5); const float* modp = (const float*)LDWS(WS_MODP); float* mod = (float*)LDWS(WS_MOD);
        for (int i = gt; i < DEPTH * BATCH * MODW; i += ngt) { const int n = i % MODW, l = i / (BATCH * MODW); float s = 0.f;
#pragma unroll
            for (int kq = 0; kq < 8; ++kq) s += modp[(size_t)kq * DEPTH * BATCH * MODW + i];
            mod[i] = s + ada_b[l * MODW + n]; }
    }
    SEAM(1);
    if (PHM(2) && IN(2)) ln_rows(FRESH_S(gw), ngw, FRESH_LANE(), LDF(0), LDF(6), (const float*)LDWS(WS_MOD), 0, 1, (bf16*)LDWS(WS_XN), nullptr);
    SEAM(2);

#pragma unroll 1
    for (int l = 0; l < DEPTH; ++l) {
        const int sb = 3 + 8 * l;
        if (PHM(3) && IN(sb + 0)) {
            float* ropec = (float*)LDWS(WS_ROPE);
            pg8::Gemm g{(const bf16*)LDWS(WS_XN), (const bf16*)LDWS(WS_WIN) + (size_t)l * INP * D}; pg8::StaticOrder<INP> S; S.init(G, FRESH_S(bx));
            pg8::EpiInProj E{(bf16*)LDWS(WS_PROJ), (float*)LDWS(WS_SSP), ropec, ropec + (size_t)M * 16};
            _Pragma("unroll 1") for (int rep = 0; rep < DUP_INPROJ; ++rep)
            pg8::gemm_phase<pg8::EpiInProj, pg8::StaticOrder<INP>, true, D, D>(lds, g, S, E, wave);
        }
        SEAM(sb + 0);
        if (PHM(4) && IN(sb + 1)) {
            { float* ropec = (float*)LDWS(WS_ROPE);
              pg8::Gemm g{(const bf16*)LDWS(WS_PROJ) + O_BQ, (const bf16*)LDWS(WS_WUP) + (size_t)l * UPN * UPK}; pg8::StaticOrder<UPN> S; S.init(G, FRESH_S(bx));
              pg8::EpiUp E{(bf16*)LDWS(WS_UPO), (const float*)LDWS(WS_SSP), ropec, ropec + (size_t)M * 16};
              pg8::gemm_phase<pg8::EpiUp, pg8::StaticOrder<UPN>, true, UPK, INP>(lds, g, S, E, wave); }
            const int lane = FRESH_LANE(), gwp = FRESH_S(gw);
            LAS char* vt = (LAS char*)(lds + FRESH_S(wave) * 4096);
            const bf16* PROJ = (const bf16*)LDWS(WS_PROJ); bf16* MIX = (bf16*)LDWS(WS_MIX); const float* mix_gain = LDF(12) + l * D;
            _Pragma("unroll 1") for (int rep = 0; rep < DUP_RET; ++rep)
            for (int u = gwp; u < 48 * 64; u += ngw) {
                int bh, blk;
                if (u < 2048) { bh = u >> 6; const int i64 = u & 63, c8 = i64 >> 3, w = i64 & 7; blk = (w < 4) ? c8 * 4 + w : 63 - (c8 * 4 + (w - 4)); }
                else { const int j = u - 2048; bh = 32 + (j >> 6); blk = j & 63; }
                const int b = bh / 6, h = bh % 6; const bf16* Pb = PROJ + (size_t)b * SEQ * INP;
                FaSrc S{Pb + O_CQ + h * 32, INP, Pb + O_CK + h * 32, INP, nullptr, 0, Pb + O_CV + h * 64, INP};
                fa_unit<2, 2, 1>(S, blk * 32, vt, MIX + (size_t)b * SEQ * D + 640 + h * 64, mix_gain + 640 + h * 64, Pb + O_CG + h * 64, lane);
            }
            _Pragma("unroll 1") for (int rep = 0; rep < DUP_DIL; ++rep)
            for (int u = gwp; u < 6144; u += ngw) {
                const int r = u & 15, qb = (u >> 4) & 7, bh = u >> 7, b = bh / 6, h = bh % 6;
                dil_unit(PROJ + (size_t)b * SEQ * INP, MIX + (size_t)b * SEQ * D, h, qb * 256, r, vt, tab + h * 3 * 132, mix_gain + h * 64, lane);
            }
        }
        SEAM(sb + 1);
        if (PHM(5) && IN(sb + 2)) {
            const int lane = FRESH_LANE(), gwp = FRESH_S(gw);
            LAS char* vt = (LAS char*)(lds + FRESH_S(wave) * 4096);
            const bf16* PROJ = (const bf16*)LDWS(WS_PROJ); const bf16* UPO = (const bf16*)LDWS(WS_UPO); bf16* MIX = (bf16*)LDWS(WS_MIX); const float* mix_gain = LDF(12) + l * D;
            _Pragma("unroll 1") for (int rep = 0; rep < DUP_MLA; ++rep)
            for (int u = gwp; u < 32 * 64; u += ngw) {
                const int bh = u >> 6, i64 = u & 63, c8 = i64 >> 3, w = i64 & 7, blk = (w < 4) ? c8 * 4 + w : 63 - (c8 * 4 + (w - 4));
                const int b = bh >> 2, h = bh & 3; const bf16* Ub = UPO + (size_t)b * SEQ * UPN;
                FaSrc S{Ub + h * 96, UPN, Ub + 384 + h * 128, UPN, PROJ + (size_t)b * SEQ * INP + O_BKR, INP, Ub + 384 + h * 128 + 64, UPN};
                fa_unit<6, 4, 0>(S, blk * 32, vt, MIX + (size_t)b * SEQ * D + 384 + h * 64, mix_gain + 384 + h * 64, nullptr, lane);
            }
        }
        SEAM(sb + 2);
        if (PHM(6) && IN(sb + 3)) {
            float* out = LDOUT(); const float* x_in = LDF(0);
            pg8::Gemm g{(const bf16*)LDWS(WS_MIX), (const bf16*)LDWS(WS_WOUT) + (size_t)l * D * D}; pg8::StaticOrder<D> S; S.init(G, FRESH_S(bx));
            pg8::EpiRes E{l == 0 ? x_in : (const float*)out, out, (const float*)LDWS(WS_MOD) + (size_t)l * BATCH * MODW + 2 * D};
            pg8::gemm_phase<pg8::EpiRes, pg8::StaticOrder<D>, true, D, D>(lds, g, S, E, wave);
        }
        SEAM(sb + 3);
        if (PHM(7) && IN(sb + 4)) _Pragma("unroll 1") for (int rep = 0; rep < DUP_LN2; ++rep) ln_rows(FRESH_S(gw), ngw, FRESH_LANE(), LDOUT(), LDF(14) + l * D, (const float*)LDWS(WS_MOD) + (size_t)l * BATCH * MODW, 3, 4, (bf16*)LDWS(WS_XN), nullptr);
        SEAM(sb + 4);
        if (PHM(8) && IN(sb + 5)) {
            pg8::Gemm g{(const bf16*)LDWS(WS_XN), (const bf16*)LDWS(WS_WGU) + (size_t)l * GU * D}; pg8::StaticOrder<GU> S; S.init(G, FRESH_S(bx));
            pg8::EpiSwiGLU E{(bf16*)LDWS(WS_PROJ)};
            _Pragma("unroll 1") for (int rep = 0; rep < DUP_GU; ++rep)
            pg8::gemm_phase<pg8::EpiSwiGLU, pg8::StaticOrder<GU>, true, D, D>(lds, g, S, E, wave);
        }
        SEAM(sb + 5);
        if (PHM(9) && IN(sb + 6)) {
            float* out = LDOUT();
            pg8::Gemm g{(const bf16*)LDWS(WS_PROJ), (const bf16*)LDWS(WS_WDN) + (size_t)l * D * FFH}; pg8::StaticOrder<D> S; S.init(G, FRESH_S(bx));
            pg8::EpiRes E{out, out, (const float*)LDWS(WS_MOD) + (size_t)l * BATCH * MODW + 5 * D};
            pg8::gemm_phase<pg8::EpiRes, pg8::StaticOrder<D>, true, FFH, FFH>(lds, g, S, E, wave);
        }
        SEAM(sb + 6);
        if (PHM(10) && IN(sb + 7)) {
            const int lane = FRESH_LANE(), gwp = FRESH_S(gw);
            float* out = LDOUT();
            if (l + 1 < DEPTH) ln_rows(gwp, ngw, lane, out, LDF(6) + (l + 1) * D, (const float*)LDWS(WS_MOD) + (size_t)(l + 1) * BATCH * MODW, 0, 1, (bf16*)LDWS(WS_XN), nullptr);
            else ln_rows(gwp, ngw, lane, out, LDF(18), nullptr, 0, 0, nullptr, out);
        }
        if (sb + 8 < NSTEPS) SEAM(sb + 7);
    }
#undef IN
#undef SEAM
}

extern "C" void kernel_launch(void* const* d_in, const int* in_sizes, int n_in, void* d_out, int out_size, void* d_ws, size_t ws_size, hipStream_t stream) {
    static int grid = 0;
    if (grid == 0) {
        if (n_in != 19 || out_size != M * D || ws_size < WS_END) { fprintf(stderr, "kernel_launch: unexpected shapes (n_in %d out %d ws %zu need %zu)\n", n_in, out_size, ws_size, (size_t)WS_END); grid = -1; return; }
        int dev = 0, cus = 0, per_cu = 0;
        if (hipGetDevice(&dev) != hipSuccess || hipDeviceGetAttribute(&cus, hipDeviceAttributeMultiprocessorCount, dev) != hipSuccess) { grid = -1; return; }
        if (hipFuncSetAttribute((const void*)fwd, hipFuncAttributeMaxDynamicSharedMemorySize, LDS_BYTES) != hipSuccess) { fprintf(stderr, "kernel_launch: hipFuncSetAttribute failed\n"); grid = -1; return; }
        if (hipOccupancyMaxActiveBlocksPerMultiprocessor(&per_cu, (const void*)fwd, NWAVES * 64, LDS_BYTES) != hipSuccess || per_cu < 1) fprintf(stderr, "kernel_launch: occupancy query reports %d\n", per_cu);
        (void)hipGetLastError();
        grid = cus;
    }
    if (grid < 0) return;
    if (hipMemsetAsync((char*)d_ws + WS_CTL, 0, CTL_ZERO_BYTES, stream) != hipSuccess) return;
    Args a{};
    for (int i = 0; i < 19; ++i) a.in[i] = (const float*)d_in[i];
    a.out = (float*)d_out; a.ws = (unsigned char*)d_ws;
    if (MK_N_LAUNCHES == 1) { a.st_lo = 0; a.st_hi = NSTEPS; hipLaunchKernelGGL(fwd, dim3(grid), dim3(NWAVES * 64), LDS_BYTES, stream, a); }
    else for (int s = 0; s < NSTEPS; ++s) { a.st_lo = s; a.st_hi = s + 1; hipLaunchKernelGGL(fwd, dim3(grid), dim3(NWAVES * 64), LDS_BYTES, stream, a); }
    const hipError_t le = hipPeekAtLastError();
    if (le != hipSuccess) fprintf(stderr, "kernel_launch: launch failed: %s\n", hipGetErrorName(le));
}
```

```cpp
#include <hip/hip_runtime.h>
#include <cstdio>
#include <cstdint>
#include <cmath>

#define LAS __attribute__((address_space(3)))
#define GAS __attribute__((address_space(1)))
#ifndef MK_N_LAUNCHES
#define MK_N_LAUNCHES 1
#endif

typedef unsigned short bf16;
#define FRESH_LANE() ({ int l_; asm volatile("v_mbcnt_lo_u32_b32 %0, -1, 0\n\tv_mbcnt_hi_u32_b32 %0, -1, %0" : "=v"(l_)); l_; })
typedef short bf16x8 __attribute__((ext_vector_type(8)));
typedef short s16x4 __attribute__((ext_vector_type(4)));
typedef float f32x2 __attribute__((ext_vector_type(2)));
typedef float f32x4 __attribute__((ext_vector_type(4)));
typedef float f32x16 __attribute__((ext_vector_type(16)));
typedef unsigned u32x2 __attribute__((ext_vector_type(2)));
typedef unsigned u32x4 __attribute__((ext_vector_type(4)));

constexpr int D = 1024, BATCH = 8, SEQ = 2048, DEPTH = 4, M = BATCH * SEQ;
constexpr int INW = 2720, INP = 2816, FFH = 2816, GU = 2 * FFH, UPK = 384, UPN = 1024, MODW = 6 * D;
constexpr int O_AQ = 0, O_AK = 384, O_AV = 768, O_BQ = 1152, O_BKR = 1536, O_CQ = 1568, O_CK = 1760, O_CV = 1952, O_CG = 2336;
constexpr float EPS = 1e-6f, LOG2E = 1.4426950408889634f;
constexpr float NEG_INF = -__builtin_huge_valf();

__device__ const unsigned char BUCKET[3][129] = {
 {0, 1, 2, 3, 4, 5, 6, 7, 8, 9, 10, 11, 12, 13, 14, 15, 16, 16, 16, 16, 16, 16, 17, 17, 17, 17, 17, 17, 17, 17, 18, 18, 18, 18, 18, 18, 18, 18, 18, 18, 19, 19, 19, 19, 19, 19, 19, 19, 19, 19, 19, 19, 19, 19, 20, 20, 20, 20, 20, 20, 20, 20, 20, 20, 20, 20, 20, 20, 20, 20, 20, 20, 20, 21, 21, 21, 21, 21, 21, 21, 21, 21, 21, 21, 21, 21, 21, 21, 21, 21, 21, 21, 21, 21, 21, 21, 21, 21, 21, 22, 22, 22, 22, 22, 22, 22, 22, 22, 22, 22, 22, 22, 22, 22, 22, 22, 22, 22, 22, 22, 22, 22, 22, 22, 22, 22, 22, 22, 22},
 {0, 4, 8, 12, 16, 16, 17, 17, 18, 18, 19, 19, 19, 19, 20, 20, 20, 20, 20, 21, 21, 21, 21, 21, 21, 22, 22, 22, 22, 22, 22, 22, 22, 22, 23, 23, 23, 23, 23, 23, 23, 23, 23, 23, 23, 23, 24, 24, 24, 24, 24, 24, 24, 24, 24, 24, 24, 24, 24, 24, 24, 24, 25, 25, 25, 25, 25, 25, 25, 25, 25, 25, 25, 25, 25, 25, 25, 25, 25, 25, 25, 25, 25, 26, 26, 26, 26, 26, 26, 26, 26, 26, 26, 26, 26, 26, 26, 26, 26, 26, 26, 26, 26, 26, 26, 26, 26, 26, 26, 26, 26, 26, 26, 27, 27, 27, 27, 27, 27, 27, 27, 27, 27, 27, 27, 27, 27, 27, 27},
 {0, 16, 18, 19, 20, 21, 21, 22, 22, 23, 23, 23, 24, 24, 24, 24, 25, 25, 25, 25, 25, 26, 26, 26, 26, 26, 26, 26, 26, 27, 27, 27, 27, 27, 27, 27, 27, 27, 27, 28, 28, 28, 28, 28, 28, 28, 28, 28, 28, 28, 28, 28, 29, 29, 29, 29, 29, 29, 29, 29, 29, 29, 29, 29, 29, 29, 29, 29, 29, 29, 30, 30, 30, 30, 30, 30, 30, 30, 30, 30, 30, 30, 30, 30, 30, 30, 30, 30, 30, 30, 30, 30, 30, 30, 30, 31, 31, 31, 31, 31, 31, 31, 31, 31, 31, 31, 31, 31, 31, 31, 31, 31, 31, 31, 31, 31, 31, 31, 31, 31, 31, 31, 31, 31, 31, 31, 31, 31, 31}};
__device__ const float INV_FREQ[16] = {0x1.0000000000000p+0f, 0x1.1feb340000000p-1f, 0x1.43d1360000000p-2f, 0x1.6c310e0000000p-3f, 0x1.99999a0000000p-4f, 0x1.ccab840000000p-5f, 0x1.030dc60000000p-5f, 0x1.235a720000000p-6f, 0x1.47ae140000000p-7f, 0x1.7089380000000p-8f, 0x1.9e7c700000000p-9f, 0x1.d22a500000000p-10f, 0x1.0624de0000000p-10f, 0x1.26d42c0000000p-11f, 0x1.4b96c00000000p-12f, 0x1.74eea60000000p-13f};
__device__ const float LOG_G[6] = {-0x1.0415d80000000p-5f, -0x1.0205660000000p-6f, -0x1.0101580000000p-7f, -0x1.0080560000000p-8f, -0x1.0040160000000p-9f, -0x1.0020060000000p-10f};

__device__ __forceinline__ unsigned cvtpk(float lo, float hi) { typedef __bf16 b2 __attribute__((ext_vector_type(2))); f32x2 v = {lo, hi}; b2 b = __builtin_convertvector(v, b2); return __builtin_bit_cast(unsigned, b); }
__device__ __forceinline__ float bf2f(unsigned short b) { return __uint_as_float((unsigned)b << 16); }
__device__ __forceinline__ float ex2(float x) { return __builtin_amdgcn_exp2f(x); }
__device__ __forceinline__ float silu_fast(float v) { return v * __builtin_amdgcn_rcpf(1.f + ex2(-v * LOG2E)); }
__device__ __forceinline__ float wave_sum(float v) {
#pragma unroll
    for (int o = 1; o < 64; o <<= 1) v += __shfl_xor(v, o);
    return v;
}
__device__ __forceinline__ float xmax32(float v) { auto r = __builtin_amdgcn_permlane32_swap(__float_as_uint(v), __float_as_uint(v), false, false); return fmaxf(__uint_as_float(r[0]), __uint_as_float(r[1])); }
__device__ __forceinline__ float xsum32(float v) { auto r = __builtin_amdgcn_permlane32_swap(__float_as_uint(v), __float_as_uint(v), false, false); return __uint_as_float(r[0]) + __uint_as_float(r[1]); }
__device__ __forceinline__ float xmax16(float v) { auto r = __builtin_amdgcn_permlane16_swap(__float_as_uint(v), __float_as_uint(v), false, false); return fmaxf(__uint_as_float(r[0]), __uint_as_float(r[1])); }
__device__ __forceinline__ float xsum16(float v) { auto r = __builtin_amdgcn_permlane16_swap(__float_as_uint(v), __float_as_uint(v), false, false); return __uint_as_float(r[0]) + __uint_as_float(r[1]); }
__device__ __forceinline__ int crow(int r, int hi) { return (r & 3) + 8 * (r >> 2) + 4 * hi; }
typedef short v4i16_t __attribute__((ext_vector_type(4)));
__device__ __forceinline__ s16x4 trrd(const LAS char* p) { return __builtin_bit_cast(s16x4, __builtin_amdgcn_ds_read_tr16_b64_v4i16((LAS v4i16_t*)p)); }

namespace pg8 {
typedef unsigned short bf16_t;
constexpr int BM = 256, BK = 64, HALF = 128, HTB = HALF * BK * 2, STAGE_BYTES = 8 * HTB, NXCD = 8, WGM = 8;
__host__ __device__ __forceinline__ int lds_byte(int r, int c) { const int st = (r >> 4) * 2 + (c >> 5), rr = r & 15, cc = c & 31, ob = rr * 64 + cc * 2; return st * 1024 + (ob ^ (((ob >> 9) & 1) << 5)); }
__host__ __device__ __forceinline__ void stage_rc(int b, int& R, int& C) { const int st = b / 1024, sb = b % 1024, swz = sb ^ (((sb >> 9) & 1) << 5); R = (st >> 1) * 16 + swz / 64; C = (st & 1) * 32 + (swz % 64) / 2; }
__host__ __device__ __forceinline__ int perm32(int rho) { const int n = rho >> 4, i = rho & 15; return 8 * (i >> 2) + 4 * n + (i & 3); }
struct Unit { int pm, pn; };
struct Gemm { const bf16_t* A; const bf16_t* Bt; };
template <int N_>
struct StaticOrder {
    static constexpr int nM = 64, nN = N_ / BM, nwg = nM * nN;
    int G, c;
    __host__ __device__ void init(int G_, int c_) { G = G_; c = c_; }
    __host__ __device__ bool next(int i, Unit& u) const {
        const long L = (long)i * G + c; if (L >= nwg) return false;
        int wgid = (int)L; { const int q = nwg / NXCD, r = nwg % NXCD, xcd = wgid % NXCD, off = wgid / NXCD; wgid = (xcd < r ? xcd * (q + 1) : r * (q + 1) + (xcd - r) * q) + off; }
        const int nig = WGM * nN, gid = wgid / nig, fm = gid * WGM, gsz = (nM - fm) < WGM ? (nM - fm) : WGM;
        u.pm = fm + ((wgid % nig) % gsz); u.pn = (wgid % nig) / gsz; return true;
    }
};

template <class Epi, class Sched, bool ALIGN_EPI, int K, int lda>
__device__ __forceinline__ void gemm_phase(LAS unsigned char* lds, const Gemm g, const Sched& S, const Epi& E, const int wid_in) {
    int wid = wid_in; asm volatile("" : "+s"(wid));
    const int lane = FRESH_LANE(), tid = wid * 64 + lane;
    const int wr = wid >> 2, wc = wid & 3, fr = lane & 15, fq = lane >> 4;
    constexpr int nt = K / BK;
    unsigned voffA[2], voffB[2];
#pragma unroll
    for (int i = 0; i < 2; ++i) { int R, C; stage_rc(tid * 16 + i * 8192, R, C); const int Rb = Epi::PERM ? ((R & ~31) + perm32(R & 31)) : R;
        voffA[i] = (unsigned)(R * lda + C) * 2u; voffB[i] = (unsigned)(Rb * K + C) * 2u; }
    constexpr size_t kstep = (size_t)(BK * 2);
    constexpr size_t hstepA = (size_t)HALF * lda * 2, hstepB = (size_t)HALF * K * 2;
    constexpr size_t tstepA = 2 * hstepA, tstepB = 2 * hstepB;
    const unsigned ldsw = (unsigned)wid * 1024u;
    const int aoff = lds_byte(wr * 64 + fr, fq * 8), boff = lds_byte(wc * 32 + fr, fq * 8);
#define PG8_SA(b, h) (((b) * 2 + (h)) * HTB)
#define PG8_SB(b, h) ((4 + (b) * 2 + (h)) * HTB)
#define PG8_STAGE(bufoff, gbase, voff) do { _Pragma("unroll") for (int _i = 0; _i < 2; ++_i) \
        __builtin_amdgcn_global_load_lds((const unsigned*)((const char*)(gbase) + (voff)[_i]), (LAS unsigned*)(lds + (bufoff) + ldsw + _i * 8192), 16, 0, 0); } while (0)
#define PG8_LDA(dst, b, h) do { _Pragma("unroll") for (int m = 0; m < 4; ++m) _Pragma("unroll") for (int k = 0; k < 2; ++k) dst[m][k] = *(const LAS bf16x8*)(lds + PG8_SA(b, h) + aoff + m * 2048 + k * 1024); } while (0)
#define PG8_LDB(dst, b, h) do { _Pragma("unroll") for (int n = 0; n < 2; ++n) _Pragma("unroll") for (int k = 0; k < 2; ++k) dst[n][k] = *(const LAS bf16x8*)(lds + PG8_SB(b, h) + boff + n * 2048 + k * 1024); } while (0)
#define PG8_MMA(ai, bj, At, Bt) do { __builtin_amdgcn_s_setprio(1); _Pragma("unroll") for (int m = 0; m < 4; ++m) _Pragma("unroll") for (int n = 0; n < 2; ++n) _Pragma("unroll") for (int k = 0; k < 2; ++k) \
        acc[ai][bj][m][n] = __builtin_amdgcn_mfma_f32_16x16x32_bf16(Bt[n][k], At[m][k], acc[ai][bj][m][n], 0, 0, 0); __builtin_amdgcn_s_setprio(0); } while (0)
#define PG8_WAIT_V(n) asm volatile("s_waitcnt vmcnt(" #n ")" ::: "memory")
#define PG8_WAIT_L(n) asm volatile("s_waitcnt lgkmcnt(" #n ")" ::: "memory")
#define PG8_BAR __builtin_amdgcn_s_barrier()
#define PG8_SCHED __builtin_amdgcn_sched_barrier(0)
    Unit cur, nxt; int ui = 0;
    if (!S.next(0, cur)) return;
    f32x4 acc[2][2][4][2];
#pragma unroll
    for (int a = 0; a < 2; ++a)
#pragma unroll
        for (int b = 0; b < 2; ++b)
#pragma unroll
            for (int m = 0; m < 4; ++m)
#pragma unroll
                for (int n = 0; n < 2; ++n) acc[a][b][m][n] = (f32x4){0.f, 0.f, 0.f, 0.f};
    bf16x8 At[4][2], B0[2][2], B1[2][2];
    const char* cA = (const char*)g.A + (size_t)cur.pm * tstepA; const char* cB = (const char*)g.Bt + (size_t)cur.pn * tstepB;
    PG8_STAGE(PG8_SB(0, 0), cB, voffB); PG8_STAGE(PG8_SB(0, 1), cB + hstepB, voffB); PG8_STAGE(PG8_SA(0, 0), cA, voffA); PG8_STAGE(PG8_SA(0, 1), cA + hstepA, voffA);
    if (wr == 1) PG8_BAR;
    PG8_WAIT_V(2); PG8_BAR;
    PG8_STAGE(PG8_SB(1, 0), cB + kstep, voffB); PG8_STAGE(PG8_SA(1, 0), cA + kstep, voffA); PG8_STAGE(PG8_SB(1, 1), cB + hstepB + kstep, voffB);
    PG8_WAIT_V(6); PG8_BAR;
    for (;;) {
        const bool has_next = S.next(ui + 1, nxt);
        const char* nA = has_next ? (const char*)g.A + (size_t)nxt.pm * tstepA : cA; const char* nB = has_next ? (const char*)g.Bt + (size_t)nxt.pn * tstepB : cB;
        for (int t = 0; t < nt; t += 2) {
            const bool last = (t == nt - 2);
            const char* a1 = cA + (size_t)(t + 1) * kstep;
            const char* a2 = last ? nA : cA + (size_t)(t + 2) * kstep; const char* b2 = last ? nB : cB + (size_t)(t + 2) * kstep;
            const char* a3 = a2 + kstep; const char* b3 = b2 + kstep;
            PG8_LDB(B0, 0, 0); PG8_LDB(B1, 0, 1); PG8_SCHED; PG8_LDA(At, 0, 0); PG8_STAGE(PG8_SA(1, 1), a1 + hstepA, voffA);
            PG8_WAIT_V(8); PG8_WAIT_L(0); PG8_BAR; PG8_MMA(0, 0, At, B0); PG8_MMA(0, 1, At, B1); PG8_BAR; PG8_SCHED;
            PG8_LDA(At, 0, 1); PG8_STAGE(PG8_SB(0, 0), b2, voffB); PG8_STAGE(PG8_SB(0, 1), b2 + hstepB, voffB); PG8_STAGE(PG8_SA(0, 0), a2, voffA);
            PG8_WAIT_V(8); PG8_WAIT_L(0); PG8_BAR; PG8_MMA(1, 0, At, B0); PG8_MMA(1, 1, At, B1); PG8_BAR; PG8_SCHED;
            PG8_LDB(B0, 1, 0); PG8_LDB(B1, 1, 1); PG8_SCHED; PG8_LDA(At, 1, 0); PG8_STAGE(PG8_SA(0, 1), a2 + hstepA, voffA);
            PG8_WAIT_V(8); PG8_WAIT_L(0); PG8_BAR; PG8_MMA(0, 0, At, B0); PG8_MMA(0, 1, At, B1); PG8_BAR; PG8_SCHED;
            PG8_LDA(At, 1, 1); PG8_STAGE(PG8_SB(1, 0), b3, voffB); PG8_STAGE(PG8_SB(1, 1), b3 + hstepB, voffB); PG8_STAGE(PG8_SA(1, 0), a3, voffA);
            PG8_WAIT_V(8); PG8_WAIT_L(0); PG8_BAR; PG8_MMA(1, 0, At, B0); PG8_MMA(1, 1, At, B1); PG8_BAR; PG8_SCHED;
        }
        if constexpr (ALIGN_EPI) { if (wr == 0) PG8_BAR; }
        E(acc, cur, wr, wc, fr, fq);
        if (!has_next) break;
#pragma unroll
        for (int a = 0; a < 2; ++a)
#pragma unroll
            for (int b = 0; b < 2; ++b)
#pragma unroll
                for (int m = 0; m < 4; ++m)
#pragma unroll
                    for (int n = 0; n < 2; ++n) acc[a][b][m][n] = (f32x4){0.f, 0.f, 0.f, 0.f};
        cur = nxt; cA = nA; cB = nB; ++ui;
        if constexpr (ALIGN_EPI) { if (wr == 1) PG8_BAR; }
    }
    PG8_WAIT_V(0);
    if constexpr (!ALIGN_EPI) { if (wr == 0) PG8_BAR; }
    PG8_BAR;
#undef PG8_SA
#undef PG8_SB
#undef PG8_STAGE
#undef PG8_LDA
#undef PG8_LDB
#undef PG8_MMA
#undef PG8_WAIT_V
#undef PG8_WAIT_L
#undef PG8_BAR
#undef PG8_SCHED
}

__device__ __forceinline__ void rope8(f32x4& v0, f32x4& v1, const float* ropec, const float* ropes, int row, int fq) {
    f32x4 p0, p1;
#pragma unroll
    for (int j = 0; j < 4; ++j) { p0[j] = __shfl_xor(v0[j], 32); p1[j] = __shfl_xor(v1[j], 32); }
    const float* cr = ropec + (size_t)row * 16 + 8 * (fq & 1); const float* sr = ropes + (size_t)row * 16 + 8 * (fq & 1);
    const f32x4 c0 = *(const f32x4*)cr, c1 = *(const f32x4*)(cr + 4), s0 = *(const f32x4*)sr, s1 = *(const f32x4*)(sr + 4);
    const float sg = (fq >> 1) ? 1.f : -1.f;
    v0 = v0 * c0 + p0 * s0 * sg; v1 = v1 * c1 + p1 * s1 * sg;
}
__device__ __forceinline__ void store8(bf16_t* p, f32x4 v0, f32x4 v1) { u32x4 w; w.x = cvtpk(v0[0], v0[1]); w.y = cvtpk(v0[2], v0[3]); w.z = cvtpk(v1[0], v1[1]); w.w = cvtpk(v1[2], v1[3]); *(u32x4*)p = w; }

struct EpiInProj {
    static constexpr bool PERM = true;
    bf16_t* O; float* ssp; const float* ropec; const float* ropes;
    __device__ __forceinline__ void operator()(const f32x4 (&acc)[2][2][4][2], const Unit& u, int wr, int wc, int fr, int fq) const {
        asm volatile("" : "+v"(fr), "+v"(fq));
#pragma unroll
        for (int bj = 0; bj < 2; ++bj) {
            const int g = u.pn * 8 + bj * 4 + wc;
            if (g >= 85) continue;
            const int col0 = g * 32 + 8 * fq;
#pragma unroll
            for (int ai = 0; ai < 2; ++ai)
#pragma unroll
                for (int m = 0; m < 4; ++m) {
                    const int row = u.pm * BM + ai * HALF + wr * 64 + m * 16 + fr;
                    f32x4 v0 = acc[ai][bj][m][0], v1 = acc[ai][bj][m][1];
                    if (g < 12) { v0 = v0 * (0.125f * LOG2E); v1 = v1 * (0.125f * LOG2E); }
                    else if (g >= 36 && g < 48) {
                        float ss = (v0[0] * v0[0] + v0[1] * v0[1]) + (v0[2] * v0[2] + v0[3] * v0[3]) + (v1[0] * v1[0] + v1[1] * v1[1]) + (v1[2] * v1[2] + v1[3] * v1[3]);
                        ss += __shfl_xor(ss, 16); ss += __shfl_xor(ss, 32);
                        if (fq == 0) ssp[(size_t)row * 12 + (g - 36)] = ss;
                    } else if (g >= 48 && g < 61) {
                        rope8(v0, v1, ropec, ropes, row, fq);
                        if (g >= 49) {
                            const int t = row & (SEQ - 1); const bool isk = g >= 55; const int hh = isk ? g - 55 : g - 49;
                            const float e = (float)(isk ? 1024 - t : t - 1024) * (LOG_G[hh] * LOG2E);
                            const float sc = ex2(e) * (isk ? 0.17677669529663687f : 1.f);
                            v0 = v0 * sc; v1 = v1 * sc;
                        }
                    }
                    store8(O + (size_t)row * INP + col0, v0, v1);
                    asm volatile("" ::: "memory");
                }
        }
    }
};
struct EpiUp {
    static constexpr bool PERM = true;
    bf16_t* O; const float* ssp; const float* ropec; const float* ropes;
    __device__ __forceinline__ void operator()(const f32x4 (&acc)[2][2][4][2], const Unit& u, int wr, int wc, int fr, int fq) const {
        asm volatile("" : "+v"(fr), "+v"(fq));
#pragma unroll
        for (int ai = 0; ai < 2; ++ai)
#pragma unroll
            for (int m = 0; m < 4; ++m) {
                asm volatile("" ::: "memory");
                const int row = u.pm * BM + ai * HALF + wr * 64 + m * 16 + fr;
                const f32x4 a0 = *(const f32x4*)(ssp + (size_t)row * 12), a1 = *(const f32x4*)(ssp + (size_t)row * 12 + 4), a2 = *(const f32x4*)(ssp + (size_t)row * 12 + 8);
                const float sq = ((a0[0] + a0[1]) + (a0[2] + a0[3])) + ((a1[0] + a1[1]) + (a1[2] + a1[3])), skv = (a2[0] + a2[1]) + (a2[2] + a2[3]);
                const float rq = rsqrtf(sq * (1.f / 256.f) + EPS) * (0.10206207261596575f * LOG2E), rkv = rsqrtf(skv * (1.f / 128.f) + EPS);
#pragma unroll
                for (int bj = 0; bj < 2; ++bj) {
                    const int g = u.pn * 8 + bj * 4 + wc;
                    if (g >= 28) continue;
                    f32x4 v0 = acc[ai][bj][m][0], v1 = acc[ai][bj][m][1];
                    if (g < 12) { if ((g % 3) == 2) rope8(v0, v1, ropec, ropes, row, fq); v0 = v0 * rq; v1 = v1 * rq; }
                    else { v0 = v0 * rkv; v1 = v1 * rkv; }
                    store8(O + (size_t)row * UPN + g * 32 + 8 * fq, v0, v1);
                }
            }
    }
};
struct EpiRes {
    static constexpr bool PERM = false;
    const float* res; float* out; const float* gate;
    __device__ __forceinline__ void operator()(const f32x4 (&acc)[2][2][4][2], const Unit& u, int wr, int wc, int fr, int fq) const {
        asm volatile("" : "+v"(fr), "+v"(fq));
        const int col0 = u.pn * BM + wc * 32 + 4 * fq; const float* gp = gate + (size_t)(u.pm >> 3) * MODW + col0;
        f32x4 gv[2][2];
#pragma unroll
        for (int bj = 0; bj < 2; ++bj)
#pragma unroll
            for (int n = 0; n < 2; ++n) gv[bj][n] = *(const f32x4*)(gp + bj * HALF + n * 16);
#pragma unroll
        for (int ai = 0; ai < 2; ++ai)
#pragma unroll
            for (int m = 0; m < 4; ++m) { const size_t off = (size_t)(u.pm * BM + ai * HALF + wr * 64 + m * 16 + fr) * D + col0;
#pragma unroll
                for (int bj = 0; bj < 2; ++bj)
#pragma unroll
                    for (int n = 0; n < 2; ++n) { const f32x4 r = *(const f32x4*)(res + off + bj * HALF + n * 16); *(f32x4*)(out + off + bj * HALF + n * 16) = r + gv[bj][n] * acc[ai][bj][m][n]; }
                if (m & 1) asm volatile("" ::: "memory"); }
    }
};
struct EpiSwiGLU {
    static constexpr bool PERM = true;
    bf16_t* O;
    __device__ __forceinline__ void operator()(const f32x4 (&acc)[2][2][4][2], const Unit& u, int wr, int wc, int fr, int fq) const {
        asm volatile("" : "+v"(fr), "+v"(fq));
        const int col0 = u.pn * HALF + wc * 32 + 8 * fq;
#pragma unroll
        for (int ai = 0; ai < 2; ++ai)
#pragma unroll
            for (int m = 0; m < 4; ++m) { const int row = u.pm * BM + ai * HALF + wr * 64 + m * 16 + fr;
                f32x4 v0, v1;
#pragma unroll
                for (int j = 0; j < 4; ++j) { v0[j] = silu_fast(acc[ai][0][m][0][j]) * acc[ai][1][m][0][j]; v1[j] = silu_fast(acc[ai][0][m][1][j]) * acc[ai][1][m][1][j]; }
                store8(O + (size_t)row * FFH + col0, v0, v1); }
    }
};
}

__device__ __forceinline__ int vt_chunk_off(int key, int c) { return (c >> 2) * 2048 + key * 64 + (((c & 3) ^ (((key >> 3) & 1) << 1)) << 4); }
__device__ __forceinline__ void vt_stage(LAS char* vt, const u32x4 (&vr)[4], int lane) {
#pragma unroll
    for (int e = 0; e < 4; ++e) *(LAS u32x4*)(vt + vt_chunk_off(8 * e + (lane >> 3), lane & 7)) = vr[e];
}

struct FaSrc { const bf16* q; int ldq; const bf16* k1; int ldk1; const bf16* k2; int ldk2; const bf16* v; int ldv; };
template <int NKS, int NKS1>
__device__ __forceinline__ void fa_load(bf16x8 (&kf)[NKS], u32x4 (&vr)[4], const FaSrc& S, int k0, int lane) {
    const int r = lane & 31, h = lane >> 5;
#pragma unroll
    for (int s = 0; s < NKS; ++s) {
        const bf16* p = (s < NKS1) ? S.k1 + (size_t)(k0 + r) * S.ldk1 + 16 * s + 8 * h : S.k2 + (size_t)(k0 + r) * S.ldk2 + 16 * (s - NKS1) + 8 * h;
        kf[s] = *(const bf16x8*)p; }
#pragma unroll
    for (int e = 0; e < 4; ++e) vr[e] = *(const u32x4*)(S.v + (size_t)(k0 + 8 * e + (lane >> 3)) * S.ldv + 8 * (lane & 7));
}
template <int NKS, bool SOFTMAX>
__device__ __forceinline__ void fa_tile(const bf16x8 (&kf)[NKS], const u32x4 (&vr)[4], const bf16x8 (&qf)[NKS], f32x16 (&O)[2], float& m, float& l, LAS char* vt, int k0, int q0, bool diag, int lane) {
    const int r = lane & 31, h = lane >> 5;
    vt_stage(vt, vr, lane);
    f32x16 S;
#pragma unroll
    for (int i = 0; i < 16; ++i) S[i] = 0.f;
#pragma unroll
    for (int s = 0; s < NKS; ++s) S = __builtin_amdgcn_mfma_f32_32x32x16_bf16(kf[s], qf[s], S, 0, 0, 0);
    if (diag) {
#pragma unroll
        for (int i = 0; i < 16; ++i) if (k0 + crow(i, h) > q0 + r) S[i] = SOFTMAX ? NEG_INF : 0.f;
    }
    if (SOFTMAX) {
        float mx = S[0];
#pragma unroll
        for (int i = 1; i < 16; ++i) mx = fmaxf(mx, S[i]);
        mx = xmax32(mx);
        const float mn = fmaxf(m, mx), ms = (mn == NEG_INF) ? 0.f : mn, alpha = ex2(m - ms);
        m = mn; l *= alpha;
#pragma unroll
        for (int i = 0; i < 16; ++i) { O[0][i] *= alpha; O[1][i] *= alpha; }
        float sum = 0.f;
#pragma unroll
        for (int i = 0; i < 16; ++i) { S[i] = ex2(S[i] - ms); sum += S[i]; }
        l += sum;
    }
    bf16x8 pf[2];
#pragma unroll
    for (int s2 = 0; s2 < 2; ++s2) { u32x4 w; w.x = cvtpk(S[8 * s2 + 0], S[8 * s2 + 1]); w.y = cvtpk(S[8 * s2 + 2], S[8 * s2 + 3]); w.z = cvtpk(S[8 * s2 + 4], S[8 * s2 + 5]); w.w = cvtpk(S[8 * s2 + 6], S[8 * s2 + 7]); pf[s2] = __builtin_bit_cast(bf16x8, w); }
    const int g16 = (lane >> 4) & 1, q = (lane & 15) >> 2, p = lane & 3;
    const int ch = 2 * g16 + (p >> 1);
    const LAS char* blo = vt + (4 * h + q) * 64 + (ch << 4) + (p & 1) * 8;
    const LAS char* bhi = vt + (8 + 4 * h + q) * 64 + ((ch ^ 2) << 4) + (p & 1) * 8;
#pragma unroll
    for (int vb = 0; vb < 2; ++vb)
#pragma unroll
        for (int s2 = 0; s2 < 2; ++s2) {
            const s16x4 lo = trrd(blo + vb * 2048 + s2 * 1024), hi = trrd(bhi + vb * 2048 + s2 * 1024);
            const bf16x8 vf = {lo[0], lo[1], lo[2], lo[3], hi[0], hi[1], hi[2], hi[3]};
            O[vb] = __builtin_amdgcn_mfma_f32_32x32x16_bf16(vf, pf[s2], O[vb], 0, 0, 0);
        }
}
template <int NKS, int NKS1, int MODE>
__device__ __forceinline__ void fa_unit(const FaSrc& S, int q0, LAS char* vt, bf16* mixrow0  , const float* gain, const bf16* gate  , int lane) {
    const int r = lane & 31, h = lane >> 5;
    bf16x8 qf[NKS];
#pragma unroll
    for (int s = 0; s < NKS; ++s) qf[s] = *(const bf16x8*)(S.q + (size_t)(q0 + r) * S.ldq + 16 * s + 8 * h);
    f32x16 O[2];
#pragma unroll
    for (int i = 0; i < 16; ++i) { O[0][i] = 0.f; O[1][i] = 0.f; }
    float m = NEG_INF, l = 0.f;
    const int nt = q0 / 32 + 1;
    bf16x8 kfA[NKS], kfB[NKS]; u32x4 vrA[4], vrB[4];
    fa_load<NKS, NKS1>(kfA, vrA, S, 0, lane);
    for (int kt = 0; kt < nt; kt += 2) {
        fa_load<NKS, NKS1>(kfB, vrB, S, (kt + 1 < nt ? kt + 1 : nt - 1) * 32, lane);
        fa_tile<NKS, MODE == 0>(kfA, vrA, qf, O, m, l, vt, kt * 32, q0, kt == nt - 1, lane);
        fa_load<NKS, NKS1>(kfA, vrA, S, (kt + 2 < nt ? kt + 2 : nt - 1) * 32, lane);
        if (kt + 1 < nt) fa_tile<NKS, MODE == 0>(kfB, vrB, qf, O, m, l, vt, (kt + 1) * 32, q0, kt + 1 == nt - 1, lane);
    }
    const size_t tok = (size_t)(q0 + r);
    if (MODE == 0) {
        const float lt = xsum32(l), inv = 1.f / lt;
        float ss = 0.f;
#pragma unroll
        for (int vb = 0; vb < 2; ++vb)
#pragma unroll
            for (int i = 0; i < 16; ++i) { O[vb][i] *= inv; ss += O[vb][i] * O[vb][i]; }
        ss = xsum32(ss);
        const float rs = rsqrtf(ss * (1.f / 64.f) + EPS);
#pragma unroll
        for (int vb = 0; vb < 2; ++vb)
#pragma unroll
            for (int g = 0; g < 4; ++g) { const int d0 = 32 * vb + 8 * g + 4 * h; const f32x4 gn = *(const f32x4*)(gain + d0);
                u32x2 w; w.x = cvtpk(O[vb][4 * g] * rs * gn[0], O[vb][4 * g + 1] * rs * gn[1]); w.y = cvtpk(O[vb][4 * g + 2] * rs * gn[2], O[vb][4 * g + 3] * rs * gn[3]);
                *(u32x2*)(mixrow0 + tok * D + d0) = w; }
    } else {
        float su = 0.f;
#pragma unroll
        for (int vb = 0; vb < 2; ++vb)
#pragma unroll
            for (int i = 0; i < 16; ++i) su += O[vb][i];
        su = xsum32(su);
        const float mu = su * (1.f / 64.f); float var = 0.f;
#pragma unroll
        for (int vb = 0; vb < 2; ++vb)
#pragma unroll
            for (int i = 0; i < 16; ++i) { O[vb][i] -= mu; var += O[vb][i] * O[vb][i]; }
        var = xsum32(var);
        const float rs = rsqrtf(var * (1.f / 64.f) + EPS);
#pragma unroll
        for (int vb = 0; vb < 2; ++vb)
#pragma unroll
            for (int g = 0; g < 4; ++g) { const int d0 = 32 * vb + 8 * g + 4 * h; const f32x4 gn = *(const f32x4*)(gain + d0);
                const u32x2 gb = *(const u32x2*)(gate + tok * INP + d0);
                const float g0 = silu_fast(__uint_as_float(gb.x << 16)), g1 = silu_fast(__uint_as_float(gb.x & 0xffff0000u)), g2 = silu_fast(__uint_as_float(gb.y << 16)), g3 = silu_fast(__uint_as_float(gb.y & 0xffff0000u));
                u32x2 w; w.x = cvtpk(O[vb][4 * g] * rs * gn[0] * g0, O[vb][4 * g + 1] * rs * gn[1] * g1); w.y = cvtpk(O[vb][4 * g + 2] * rs * gn[2] * g2, O[vb][4 * g + 3] * rs * gn[3] * g3);
                *(u32x2*)(mixrow0 + tok * D + d0) = w; }
    }
}

__device__ __forceinline__ void ret_pass1(const bf16* Pb  , int h, int n, float* GTu  , LAS char* kt, LAS char* vt, int lane) {
    const int q4 = lane >> 4, q = (lane & 15) >> 2, pp = lane & 3, sw = (q4 & 1) << 1;
    f32x4 acc[2][4];
#pragma unroll
    for (int mb = 0; mb < 2; ++mb)
#pragma unroll
        for (int nb = 0; nb < 4; ++nb) acc[mb][nb] = (f32x4){0.f, 0.f, 0.f, 0.f};
    const bf16* kp = Pb + (size_t)(128 * n) * INP + O_CK + h * 32; const bf16* vp = Pb + (size_t)(128 * n) * INP + O_CV + h * 64;
    u32x4 kr[2], vr[4];
#pragma unroll
    for (int e = 0; e < 2; ++e) kr[e] = *(const u32x4*)(kp + (size_t)(16 * e + (lane >> 2)) * INP + 8 * (lane & 3));
#pragma unroll
    for (int e = 0; e < 4; ++e) vr[e] = *(const u32x4*)(vp + (size_t)(8 * e + (lane >> 3)) * INP + 8 * (lane & 7));
#pragma unroll 1
    for (int st = 0; st < 4; ++st) {
#pragma unroll
        for (int e = 0; e < 2; ++e) *(LAS u32x4*)(kt + vt_chunk_off(16 * e + (lane >> 2), lane & 3)) = kr[e];
        vt_stage(vt, vr, lane);
        const int nx = st < 3 ? st + 1 : 3;
#pragma unroll
        for (int e = 0; e < 2; ++e) kr[e] = *(const u32x4*)(kp + (size_t)(32 * nx + 16 * e + (lane >> 2)) * INP + 8 * (lane & 3));
#pragma unroll
        for (int e = 0; e < 4; ++e) vr[e] = *(const u32x4*)(vp + (size_t)(32 * nx + 8 * e + (lane >> 3)) * INP + 8 * (lane & 7));
        const LAS char* kbase = kt + (8 * q4 + q) * 64 + (pp & 1) * 8; const LAS char* vbase = vt + (8 * q4 + q) * 64 + (pp & 1) * 8;
        bf16x8 af[2], bfr[4];
#pragma unroll
        for (int mb = 0; mb < 2; ++mb) { const LAS char* pa = kbase + (((2 * mb + (pp >> 1)) ^ sw) << 4); const s16x4 lo = trrd(pa), hi = trrd(pa + 256); af[mb] = (bf16x8){lo[0], lo[1], lo[2], lo[3], hi[0], hi[1], hi[2], hi[3]}; }
#pragma unroll
        for (int nb = 0; nb < 4; ++nb) { const LAS char* pa = vbase + (nb >> 1) * 2048 + (((2 * (nb & 1) + (pp >> 1)) ^ sw) << 4); const s16x4 lo = trrd(pa), hi = trrd(pa + 256); bfr[nb] = (bf16x8){lo[0], lo[1], lo[2], lo[3], hi[0], hi[1], hi[2], hi[3]}; }
#pragma unroll
        for (int mb = 0; mb < 2; ++mb)
#pragma unroll
            for (int nb = 0; nb < 4; ++nb) acc[mb][nb] = __builtin_amdgcn_mfma_f32_16x16x32_bf16(af[mb], bfr[nb], acc[mb][nb], 0, 0, 0);
    }
#pragma unroll
    for (int mb = 0; mb < 2; ++mb)
#pragma unroll
        for (int nb = 0; nb < 4; ++nb) *(f32x4*)(GTu + (16 * nb + (lane & 15)) * 32 + 16 * mb + 4 * q4) = acc[mb][nb];
}
__device__ __forceinline__ void ret_pass2(const FaSrc& S, int n, int j, const float* GTbh  , LAS char* vt, bf16* mixrow0, const float* gain, const bf16* gate, int lane) {
    const int r = lane & 31, h = lane >> 5, q0 = 128 * n + 32 * j;
    bf16x8 qf[2];
#pragma unroll
    for (int s = 0; s < 2; ++s) qf[s] = *(const bf16x8*)(S.q + (size_t)(q0 + r) * S.ldq + 16 * s + 8 * h);
    f32x16 O[2];
#pragma unroll
    for (int i = 0; i < 16; ++i) { O[0][i] = 0.f; O[1][i] = 0.f; }
    float m = 0.f, l = 0.f;
    bf16x8 kfA[2], kfB[2]; u32x4 vrA[4], vrB[4];
    const int t0 = 4 * n, nt = j + 1;
    fa_load<2, 2>(kfA, vrA, S, t0 * 32, lane);
    f32x4 ff[2][2][2];
#pragma unroll
    for (int vb = 0; vb < 2; ++vb)
#pragma unroll
        for (int s = 0; s < 2; ++s) { ff[vb][s][0] = (f32x4){0.f, 0.f, 0.f, 0.f}; ff[vb][s][1] = (f32x4){0.f, 0.f, 0.f, 0.f}; }
#pragma unroll 1
    for (int mc = 0; mc < n; ++mc) {
        const float* gp = GTbh + (size_t)mc * 2048 + (size_t)r * 32 + 8 * h;
#pragma unroll
        for (int vb = 0; vb < 2; ++vb)
#pragma unroll
            for (int s = 0; s < 2; ++s) { ff[vb][s][0] += *(const f32x4*)(gp + vb * 1024 + 16 * s); ff[vb][s][1] += *(const f32x4*)(gp + vb * 1024 + 16 * s + 4); }
    }
#pragma unroll
    for (int vb = 0; vb < 2; ++vb)
#pragma unroll
        for (int s = 0; s < 2; ++s) { u32x4 w; w.x = cvtpk(ff[vb][s][0][0], ff[vb][s][0][1]); w.y = cvtpk(ff[vb][s][0][2], ff[vb][s][0][3]); w.z = cvtpk(ff[vb][s][1][0], ff[vb][s][1][1]); w.w = cvtpk(ff[vb][s][1][2], ff[vb][s][1][3]);
            O[vb] = __builtin_amdgcn_mfma_f32_32x32x16_bf16(__builtin_bit_cast(bf16x8, w), qf[s], O[vb], 0, 0, 0); }
    for (int kt = 0; kt < nt; kt += 2) {
        fa_load<2, 2>(kfB, vrB, S, (t0 + (kt + 1 < nt ? kt + 1 : nt - 1)) * 32, lane);
        fa_tile<2, false>(kfA, vrA, qf, O, m, l, vt, (t0 + kt) * 32, q0, kt == nt - 1, lane);
        fa_load<2, 2>(kfA, vrA, S, (t0 + (kt + 2 < nt ? kt + 2 : nt - 1)) * 32, lane);
        if (kt + 1 < nt) fa_tile<2, false>(kfB, vrB, qf, O, m, l, vt, (t0 + kt + 1) * 32, q0, kt + 1 == nt - 1, lane);
    }
    const size_t tok = (size_t)(q0 + r);
    float su = 0.f;
#pragma unroll
    for (int vb = 0; vb < 2; ++vb)
#pragma unroll
        for (int i = 0; i < 16; ++i) su += O[vb][i];
    su = xsum32(su);
    const float mu = su * (1.f / 64.f); float var = 0.f;
#pragma unroll
    for (int vb = 0; vb < 2; ++vb)
#pragma unroll
        for (int i = 0; i < 16; ++i) { O[vb][i] -= mu; var += O[vb][i] * O[vb][i]; }
    var = xsum32(var);
    const float rs = rsqrtf(var * (1.f / 64.f) + EPS);
#pragma unroll
    for (int vb = 0; vb < 2; ++vb)
#pragma unroll
        for (int g = 0; g < 4; ++g) { const int d0 = 32 * vb + 8 * g + 4 * h; const f32x4 gn = *(const f32x4*)(gain + d0);
            const u32x2 gb = *(const u32x2*)(gate + tok * INP + d0);
            const float g0 = silu_fast(__uint_as_float(gb.x << 16)), g1 = silu_fast(__uint_as_float(gb.x & 0xffff0000u)), g2 = silu_fast(__uint_as_float(gb.y << 16)), g3 = silu_fast(__uint_as_float(gb.y & 0xffff0000u));
            u32x2 w; w.x = cvtpk(O[vb][4 * g] * rs * gn[0] * g0, O[vb][4 * g + 1] * rs * gn[1] * g1); w.y = cvtpk(O[vb][4 * g + 2] * rs * gn[2] * g2, O[vb][4 * g + 3] * rs * gn[3] * g3);
            *(u32x2*)(mixrow0 + tok * D + d0) = w; }
}

__device__ __forceinline__ void dil_params(int si, int n3, int n2, int s2s, int s1s, int T0, int r, int& kb, int& sh, int& p) {
    if (si < n3) { p = 2; sh = 4; kb = 512 * si + r; }
    else if (si < n3 + n2) { const int s = s2s + (si - n3); p = 1; sh = 2; kb = 4 * ((T0 >> 2) + (r >> 2) - 128 + 32 * s) + (r & 3); }
    else { const int s = s1s + (si - n3 - n2); p = 0; sh = 0; kb = T0 - 128 + 32 * s; }
}
__device__ __forceinline__ int clampi(int v, int lo, int hi) { return v < lo ? lo : (v > hi ? hi : v); }
__device__ __forceinline__ void dil_load(bf16x8 (&kf)[2][2], u32x4 (&vr)[4], const bf16* P, int h, int kb, int sh, int lane) {
    const int mrow = lane & 15, q4 = lane >> 4;
#pragma unroll
    for (int a = 0; a < 2; ++a) { const int kk = 8 * (mrow >> 2) + 4 * a + (mrow & 3); const int tk = clampi(kb + (kk << sh), 0, SEQ - 1);
        const bf16* p = P + (size_t)tk * INP + O_AK + h * 64 + 8 * q4;
        kf[a][0] = *(const bf16x8*)p; kf[a][1] = *(const bf16x8*)(p + 32); }
#pragma unroll
    for (int e = 0; e < 4; ++e) { const int kk = 8 * e + (lane >> 3); const int tk = clampi(kb + (kk << sh), 0, SEQ - 1);
        vr[e] = *(const u32x4*)(P + (size_t)tk * INP + O_AV + h * 64 + 8 * (lane & 7)); }
}
__device__ __forceinline__ void dil_step(const bf16x8 (&kf)[2][2], const u32x4 (&vr)[4], bf16x8 qf0, bf16x8 qf1, f32x4 (&O)[4], float& m, float& l, LAS char* vt, const LAS float* tabh, int kb, int sh, int p, int tq, int lane) {
    const int q4 = lane >> 4;
    vt_stage(vt, vr, lane);
    f32x4 S[2];
#pragma unroll
    for (int a = 0; a < 2; ++a) { S[a] = (f32x4){0.f, 0.f, 0.f, 0.f};
        S[a] = __builtin_amdgcn_mfma_f32_16x16x32_bf16(kf[a][0], qf0, S[a], 0, 0, 0);
        S[a] = __builtin_amdgcn_mfma_f32_16x16x32_bf16(kf[a][1], qf1, S[a], 0, 0, 0); }
    const int jq = (tq - kb) >> sh;
    float sc[8];
#pragma unroll
    for (int a = 0; a < 2; ++a)
#pragma unroll
        for (int i = 0; i < 4; ++i) { const int kk = 8 * q4 + 4 * a + i, jidx = jq - kk;
            const bool valid = ((unsigned)jidx <= 128u) && (kb + (kk << sh) >= 0);
            const float b = tabh[p * 132 + clampi(jidx, 0, 128)];
            sc[4 * a + i] = (S[a][i] + b) + (valid ? 0.f : NEG_INF); }
    float mx = sc[0];
#pragma unroll
    for (int i = 1; i < 8; ++i) mx = fmaxf(mx, sc[i]);
    mx = xmax32(xmax16(mx));
    const float mn = fmaxf(m, mx), ms = (mn == NEG_INF) ? 0.f : mn, alpha = ex2(m - ms);
    m = mn; l *= alpha;
#pragma unroll
    for (int db = 0; db < 4; ++db) O[db] = O[db] * alpha;
    float sum = 0.f;
#pragma unroll
    for (int i = 0; i < 8; ++i) { sc[i] = ex2(sc[i] - ms); sum += sc[i]; }
    l += sum;
    u32x4 w; w.x = cvtpk(sc[0], sc[1]); w.y = cvtpk(sc[2], sc[3]); w.z = cvtpk(sc[4], sc[5]); w.w = cvtpk(sc[6], sc[7]);
    const bf16x8 pf = __builtin_bit_cast(bf16x8, w);
    const int q = (lane & 15) >> 2, pp = lane & 3, sw = (q4 & 1) << 1;
    const LAS char* base = vt + (8 * q4 + q) * 64 + (pp & 1) * 8;
#pragma unroll
    for (int db = 0; db < 4; ++db) {
        const int ch = 2 * (db & 1) + (pp >> 1);
        const LAS char* pa = base + (db >> 1) * 2048 + ((ch ^ sw) << 4);
        const s16x4 lo = trrd(pa), hi = trrd(pa + 4 * 64);
        const bf16x8 vf = {lo[0], lo[1], lo[2], lo[3], hi[0], hi[1], hi[2], hi[3]};
        O[db] = __builtin_amdgcn_mfma_f32_16x16x32_bf16(vf, pf, O[db], 0, 0, 0);
    }
}
__device__ __forceinline__ void dil_unit(const bf16* P, bf16* MX, int h, int T0, int r, LAS char* vt, const LAS float* tabh, const float* gain, int lane) {
    const int n = lane & 15, q4 = lane >> 4, tq = T0 + 16 * n + r;
    const bf16* qp = P + (size_t)tq * INP + O_AQ + h * 64 + 8 * q4;
    const bf16x8 qf0 = *(const bf16x8*)qp, qf1 = *(const bf16x8*)(qp + 32);
    f32x4 O[4];
#pragma unroll
    for (int db = 0; db < 4; ++db) O[db] = (f32x4){0.f, 0.f, 0.f, 0.f};
    float m = NEG_INF, l = 0.f;
    const int n3 = (T0 >> 9) + 1, s2s = (T0 == 0) ? 3 : ((T0 == 256) ? 1 : 0), n2 = 6 - s2s, s1s = (T0 == 0) ? 4 : 0, ns = n3 + n2 + 12 - s1s;
    bf16x8 kfA[2][2], kfB[2][2]; u32x4 vrA[4], vrB[4];
    int kbA, shA, pA, kbB = 0, shB = 0, pB = 0;
    dil_params(0, n3, n2, s2s, s1s, T0, r, kbA, shA, pA); dil_load(kfA, vrA, P, h, kbA, shA, lane);
    for (int si = 0; si < ns; si += 2) {
        dil_params(si + 1 < ns ? si + 1 : ns - 1, n3, n2, s2s, s1s, T0, r, kbB, shB, pB); dil_load(kfB, vrB, P, h, kbB, shB, lane);
        dil_step(kfA, vrA, qf0, qf1, O, m, l, vt, tabh, kbA, shA, pA, tq, lane);
        dil_params(si + 2 < ns ? si + 2 : ns - 1, n3, n2, s2s, s1s, T0, r, kbA, shA, pA); dil_load(kfA, vrA, P, h, kbA, shA, lane);
        if (si + 1 < ns) dil_step(kfB, vrB, qf0, qf1, O, m, l, vt, tabh, kbB, shB, pB, tq, lane);
    }
    const float lt = xsum32(xsum16(l));
    const float inv = 1.f / lt; float ss = 0.f;
#pragma unroll
    for (int db = 0; db < 4; ++db) { O[db] = O[db] * inv; ss += (O[db][0] * O[db][0] + O[db][1] * O[db][1]) + (O[db][2] * O[db][2] + O[db][3] * O[db][3]); }
    ss = xsum32(xsum16(ss));
    const float rs = rsqrtf(ss * (1.f / 64.f) + EPS);
#pragma unroll
    for (int db = 0; db < 4; ++db) { const int d0 = 16 * db + 4 * q4; const f32x4 gn = *(const f32x4*)(gain + d0);
        u32x2 w; w.x = cvtpk(O[db][0] * rs * gn[0], O[db][1] * rs * gn[1]); w.y = cvtpk(O[db][2] * rs * gn[2], O[db][3] * rs * gn[3]);
        *(u32x2*)(MX + (size_t)tq * D + h * 64 + d0) = w; }
}

constexpr size_t MiB = 1u << 20;
constexpr size_t WS_CTL = 0, CTL_ZERO_BYTES = 1 * MiB;
constexpr size_t WS_MOD = 1 * MiB, WS_MODP = 2 * MiB, WS_ROPE = 9 * MiB, WS_SSP = 11 * MiB;
constexpr size_t WS_WIN = 12 * MiB, WS_WOUT = 34 * MiB, WS_WGU = 42 * MiB, WS_WDN = 86 * MiB, WS_WUP = 108 * MiB;
constexpr size_t WS_XN = 112 * MiB, WS_MIX = 144 * MiB, WS_UPO = 176 * MiB, WS_PROJ = 208 * MiB, WS_GT = 296 * MiB, WS_END = 304 * MiB;
constexpr int CW_BAR = 4096;
constexpr int RING_BYTES = 131072, LDSCTL_OFF = RING_BYTES, MISC_OFF = LDSCTL_OFF + 320, PTAB_OFF = LDSCTL_OFF + 512, TAB_OFF = LDSCTL_OFF + 768, LDS_BYTES = TAB_OFF + 6 * 3 * 132 * 4 + 64;
static_assert(LDS_BYTES <= 160 * 1024, "LDS");
constexpr int NWAVES = 8;
constexpr int NSTEPS = 3 + 8 * DEPTH;

#define XB_TMO      128
#define XB_XCNT(j)  (256  + 64 * (j))
#define XB_XSUB(j)  (1280 + 64 * (j))
#define XB_XGEN(j)  (2304 + 64 * (j))
#define XB_TOP      3328
#define XB_TOPGEN   3392
#define XCD_BAR_WORDS 3456
#define XB_SPIN_CAP (1u << 18)
typedef GAS unsigned gu32;
__device__ __forceinline__ unsigned xb_ld(gu32* p)              { return __hip_atomic_load(p, __ATOMIC_RELAXED, __HIP_MEMORY_SCOPE_AGENT); }
__device__ __forceinline__ unsigned xb_add(gu32* p, unsigned v) { return __hip_atomic_fetch_add(p, v, __ATOMIC_RELAXED, __HIP_MEMORY_SCOPE_AGENT); }
__device__ __forceinline__ unsigned xb_xcc_id() { return (unsigned)__builtin_amdgcn_s_getreg((3 << 11) | 20) & 0xFu; }
#define XB_SPIN(cond, bar) do { unsigned _sp = 0; while (cond) { __builtin_amdgcn_s_sleep(1); \
    if ((++_sp & 255u) == 0u) { if (xb_ld(&(bar)[XB_TMO])) break; if (_sp > XB_SPIN_CAP) { xb_add(&(bar)[XB_TMO], 1u); break; } } } } while (0)
struct XcdBarrier { unsigned x; volatile LAS unsigned* st; };
__device__ __forceinline__ XcdBarrier xcd_barrier_post(gu32* bar, volatile LAS unsigned* st, bool t0) {
    XcdBarrier b; b.x = xb_xcc_id(); b.st = st;
    if (t0) (void)xb_add(&bar[XB_XCNT(b.x)], 1u);
    return b;
}
__device__ __forceinline__ void xcd_barrier_complete(gu32* bar, unsigned x, unsigned& nloc, unsigned& nx) {
    const unsigned G = gridDim.x * gridDim.y * gridDim.z;
    unsigned sum, cnt, mine, sp = 0u;
    for (;;) {
        sum = 0u; cnt = 0u; mine = 0u;
#pragma unroll
        for (unsigned j = 0; j < 16; ++j) { const unsigned c = xb_ld(&bar[XB_XCNT(j)]); sum += c; cnt += (c > 0u) ? 1u : 0u; mine = (j == x) ? c : mine; }
        if (sum == G) break;
        __builtin_amdgcn_s_sleep(1);
        if ((++sp & 255u) == 0u) { if (xb_ld(&bar[XB_TMO])) break; if (sp > XB_SPIN_CAP) { xb_add(&bar[XB_TMO], 1u); break; } }
    }
    nloc = mine > 0u ? mine : 1u; nx = cnt > 0u ? cnt : 1u;
}
__device__ __forceinline__ void xcd_barrier(const XcdBarrier& b, gu32* bar_, int wave) {
    asm volatile("s_waitcnt vmcnt(0)" ::: "memory");
    __syncthreads();
    if (wave == 0 && FRESH_LANE() == 0) {
        unsigned long long bv_ = (unsigned long long)bar_; asm volatile("" : "+v"(bv_)); gu32* bar = (gu32*)bv_;
        __builtin_amdgcn_s_waitcnt(0);
        unsigned nloc = b.st[0], nx = b.st[1];
        if (nloc == 0u) { xcd_barrier_complete(bar, b.x, nloc, nx); b.st[0] = nloc; b.st[1] = nx; }
        const unsigned old = xb_add(&bar[XB_XSUB(b.x)], 1u);
        const unsigned gen = old / nloc;
        if (old + 1u == (gen + 1u) * nloc) {
            __builtin_amdgcn_fence(__ATOMIC_RELEASE, "agent");
            asm volatile("s_waitcnt vmcnt(0)" ::: "memory");
            const unsigned og = xb_add(&bar[XB_TOP], 1u);
            const unsigned tg = og / nx;
            if (og + 1u == (tg + 1u) * nx) xb_add(&bar[XB_TOPGEN], 1u);
            else XB_SPIN(xb_ld(&bar[XB_TOPGEN]) == tg, bar);
            __builtin_amdgcn_fence(__ATOMIC_ACQUIRE, "agent");
            xb_add(&bar[XB_XGEN(b.x)], 1u);
            asm volatile("s_waitcnt vmcnt(0)" ::: "memory");
        } else {
            XB_SPIN(xb_ld(&bar[XB_XGEN(b.x)]) == gen, bar);
            __builtin_amdgcn_fence(__ATOMIC_ACQUIRE, "agent");
            asm volatile("s_waitcnt vmcnt(0)" ::: "memory");
        }
    }
    __syncthreads();
}

__device__ __forceinline__ void transpose_item(const float* W, int K, int N, bf16* WT, int k0, int n0, int orow0, LAS float* scr, int lane) {
#pragma unroll 8
    for (int i = 0; i < 32; ++i) { const int kk = 2 * i + (lane >> 5); scr[kk * 33 + (lane & 31)] = W[(size_t)(k0 + kk) * N + n0 + (lane & 31)]; }
    asm volatile("s_waitcnt lgkmcnt(0)" ::: "memory");
    const int c = lane & 7;
#pragma unroll
    for (int j = 0; j < 4; ++j) { const int n = (lane >> 3) + 8 * j; const LAS float* s = scr + (8 * c) * 33 + n;
        u32x4 o; o.x = cvtpk(s[0 * 33], s[1 * 33]); o.y = cvtpk(s[2 * 33], s[3 * 33]); o.z = cvtpk(s[4 * 33], s[5 * 33]); o.w = cvtpk(s[6 * 33], s[7 * 33]);
        *(u32x4*)(WT + (size_t)(orow0 + n) * K + k0 + 8 * c) = o; }
    asm volatile("s_waitcnt lgkmcnt(0)" ::: "memory");
}
__device__ __forceinline__ void ln_rows(int gw, int ngw, int lane, const float* xin, const float* g, const float* modl, int ch_sh, int ch_sc, bf16* xn, float* outf) {
    for (int m = gw; m < M; m += ngw) {
        const f32x4* xr = (const f32x4*)(xin + (size_t)m * D) + lane;
        f32x4 v[4]; float s = 0.f;
#pragma unroll
        for (int j = 0; j < 4; ++j) { v[j] = xr[64 * j]; s += (v[j][0] * v[j][0] + v[j][1] * v[j][1]) + (v[j][2] * v[j][2] + v[j][3] * v[j][3]); }
        const float rs = rsqrtf(wave_sum(s) * (1.f / D) + EPS);
        const int b = m / SEQ;
#pragma unroll
        for (int j = 0; j < 4; ++j) { const int n0 = 4 * lane + 256 * j; f32x4 y = v[j] * rs * *(const f32x4*)(g + n0);
            if (modl) { const f32x4 sc = *(const f32x4*)(modl + (size_t)b * MODW + ch_sc * D + n0), sh = *(const f32x4*)(modl + (size_t)b * MODW + ch_sh * D + n0); y = y * (sc + 1.f) + sh; }
            if (xn) { u32x2 w; w.x = cvtpk(y[0], y[1]); w.y = cvtpk(y[2], y[3]); *(u32x2*)(xn + (size_t)m * D + n0) = w; }
            else *(f32x4*)(outf + (size_t)m * D + n0) = y; }
    }
}

struct Args { const float* in[19]; float* out; unsigned char* ws; int st_lo, st_hi; };
__global__ void __launch_bounds__(NWAVES * 64, 2) fwd(Args args) {
    extern __shared__ __attribute__((aligned(16))) unsigned char lds_raw[];
    LAS unsigned char* lds = (LAS unsigned char*)lds_raw;
    volatile LAS unsigned* MISC = (volatile LAS unsigned*)(lds + MISC_OFF);
    const int wave = __builtin_amdgcn_readfirstlane(threadIdx.x >> 6);
    const int G = gridDim.x; const int bx = blockIdx.x; const int vcu = (G % 8 == 0) ? (bx % 8) * (G / 8) + bx / 8 : bx;
    const int gw = vcu * NWAVES + wave, ngw = G * NWAVES, ngt = ngw * 64;
    LAS unsigned long long* ptab = (LAS unsigned long long*)(lds + PTAB_OFF);
    const int tid = wave * 64 + FRESH_LANE();
    if (tid == 0) {
#pragma unroll
        for (int i = 0; i < 19; ++i) ptab[i] = (unsigned long long)args.in[i];
        ptab[19] = (unsigned long long)args.out; ptab[20] = (unsigned long long)args.ws;
    }
#define FRESH_TID() (wave * 64 + FRESH_LANE())
#define FRESH_S(x) ({ int s_ = (x); asm volatile("" : "+s"(s_)); s_; })
#define LDP_RAW(i) ({ const unsigned long long v_ = ptab[i]; const unsigned lo_ = __builtin_amdgcn_readfirstlane((unsigned)v_), hi_ = __builtin_amdgcn_readfirstlane((unsigned)(v_ >> 32)); ((unsigned long long)hi_ << 32) | lo_; })
#define LDF(i) ((const float*)(const GAS float*)LDP_RAW(i))
#define LDWS(off) ((unsigned char*)(GAS unsigned char*)(LDP_RAW(20) + (off)))
#define LDOUT() ((float*)(GAS float*)LDP_RAW(19))
    for (int u = tid; u < (PTAB_OFF - LDSCTL_OFF) / 4; u += NWAVES * 64) ((LAS unsigned*)(lds + LDSCTL_OFF))[u] = 0u;
    LAS float* tab = (LAS float*)(lds + TAB_OFF);
    { const float* rel_bias = args.in[3];
      for (int u = tid; u < 6 * 3 * 129; u += NWAVES * 64) { const int j = u % 129, hp = u / 129, p = hp % 3, h = hp / 3; tab[hp * 132 + j] = rel_bias[BUCKET[p][j] * 6 + h] * LOG2E; } }
    __syncthreads();
    const int lo = args.st_lo, hi = args.st_hi;
    const XcdBarrier bar = xcd_barrier_post((gu32*)(args.ws + WS_CTL) + CW_BAR, MISC + 8, tid == 0);
#ifndef PHASE_MASK
#define PHASE_MASK 0xffff
#endif
#ifndef DUP_RET
#define DUP_RET 1
#endif
#ifndef DUP_DIL
#define DUP_DIL 1
#endif
#ifndef DUP_MLA
#define DUP_MLA 1
#endif
#ifndef DUP_INPROJ
#define DUP_INPROJ 1
#endif
#ifndef DUP_GU
#define DUP_GU 1
#endif
#ifndef DUP_LN2
#define DUP_LN2 1
#endif
#define PHM(b) ((PHASE_MASK >> (b)) & 1)
#define IN(k) (lo <= (k) && (k) < hi)
#define SEAM(k) do { if (IN(k) && IN((k) + 1)) xcd_barrier(bar, (gu32*)(args.ws + WS_CTL) + CW_BAR, wave); } while (0)

    if (PHM(0) && IN(0)) {
        const int tidp = FRESH_TID(), lane = tidp & 63, gt = gw * 64 + lane;
        const float* c_in = LDF(1); const int* pos = (const int*)LDF(2); const float* ada_w = LDF(4); const float* w_in = LDF(7);
        const float* q_norm = LDF(8); const float* kv_norm = LDF(9); const float* w_uq = LDF(10); const float* w_ukv = LDF(11);
        const float* w_out = LDF(13); const float* w_gate = LDF(15); const float* w_up = LDF(16); const float* w_down = LDF(17);
        float* modp = (float*)LDWS(WS_MODP); float* ropec = (float*)LDWS(WS_ROPE); float* ropes = ropec + (size_t)M * 16;
        bf16* Win_t = (bf16*)LDWS(WS_WIN); bf16* Wout_t = (bf16*)LDWS(WS_WOUT); bf16* Wgu_t = (bf16*)LDWS(WS_WGU); bf16* Wdn_t = (bf16*)LDWS(WS_WDN); bf16* Wup_t = (bf16*)LDWS(WS_WUP);
        LAS float* scr = (LAS float*)(lds + wave * 8704);
        LAS float* cact = (LAS float*)(lds + 73728);
        for (int i = tidp; i < BATCH * D; i += NWAVES * 64) { const int b = i / D, k = i % D; const float v = c_in[i]; cact[k * 8 + b] = v / (1.f + expf(-v)); }
        __syncthreads();
        for (int it = gw; it < DEPTH * 96 * 8; it += ngw) {
            const int kq = it & 7, cg = (it >> 3) % 96, l = it / (96 * 8), n = cg * 64 + lane;
            const float* wp = ada_w + ((size_t)l * D + kq * 128) * MODW + n;
            float a[8];
#pragma unroll
            for (int b = 0; b < 8; ++b) a[b] = 0.f;
#pragma unroll 16
            for (int k = 0; k < 128; ++k) { const float wv = wp[(size_t)k * MODW]; const f32x4 c0 = *(const LAS f32x4*)(cact + (kq * 128 + k) * 8), c1 = *(const LAS f32x4*)(cact + (kq * 128 + k) * 8 + 4);
                a[0] += c0[0] * wv; a[1] += c0[1] * wv; a[2] += c0[2] * wv; a[3] += c0[3] * wv; a[4] += c1[0] * wv; a[5] += c1[1] * wv; a[6] += c1[2] * wv; a[7] += c1[3] * wv; }
#pragma unroll
            for (int b = 0; b < 8; ++b) modp[(((size_t)kq * DEPTH + l) * BATCH + b) * MODW + n] = a[b];
        }
        constexpr int I_IN = 16 * 85, I_OUT = 16 * 32, I_G = 16 * 88, I_DN = 44 * 32, I_L = I_IN + I_OUT + 2 * I_G + I_DN;
        for (int it = gw; it < DEPTH * I_L; it += ngw) {
            const int l = it / I_L; int r = it % I_L;
            if (r < I_IN) { const int kb = r / 85, nb = r % 85; transpose_item(w_in + (size_t)l * D * INW, D, INW, Win_t + (size_t)l * INP * D, 64 * kb, 32 * nb, 32 * nb, scr, lane); continue; } r -= I_IN;
            if (r < I_OUT) { const int kb = r / 32, nb = r % 32; transpose_item(w_out + (size_t)l * D * D, D, D, Wout_t + (size_t)l * D * D, 64 * kb, 32 * nb, 32 * nb, scr, lane); continue; } r -= I_OUT;
            if (r < I_G) { const int kb = r / 88, nb = r % 88, n0 = 32 * nb; transpose_item(w_gate + (size_t)l * D * FFH, D, FFH, Wgu_t + (size_t)l * GU * D, 64 * kb, n0, 256 * (n0 >> 7) + (n0 & 127), scr, lane); continue; } r -= I_G;
            if (r < I_G) { const int kb = r / 88, nb = r % 88, n0 = 32 * nb; transpose_item(w_up + (size_t)l * D * FFH, D, FFH, Wgu_t + (size_t)l * GU * D, 64 * kb, n0, 256 * (n0 >> 7) + 128 + (n0 & 127), scr, lane); continue; } r -= I_G;
            { const int kb = r / 32, nb = r % 32; transpose_item(w_down + (size_t)l * FFH * D, FFH, D, Wdn_t + (size_t)l * D * FFH, 64 * kb, 32 * nb, 32 * nb, scr, lane); }
        }
        for (int i = gt; i < DEPTH * 96 * D / 8; i += ngt) { const int l = i / (96 * D / 8), r = i % (96 * D / 8); *(u32x4*)(Win_t + (size_t)l * INP * D + (size_t)INW * D + (size_t)r * 8) = (u32x4){0u, 0u, 0u, 0u}; }
        for (int i = gt; i < DEPTH * UPN * UPK; i += ngt) { const int l = i / (UPN * UPK), rr = i % (UPN * UPK), n = rr / UPK, k = rr % UPK; float v = 0.f;
            if (n < 384) { if (k < 256) v = q_norm[l * 256 + k] * w_uq[((size_t)l * 256 + k) * 384 + n]; }
            else if (n < 896) { if (k >= 256) v = kv_norm[l * 128 + (k - 256)] * w_ukv[((size_t)l * 128 + (k - 256)) * 512 + (n - 384)]; }
            Wup_t[i] = (bf16)(cvtpk(v, 0.f) & 0xffffu); }
        for (int i = gt; i < M * 16; i += ngt) { const int m = i >> 4, f = i & 15; const float ang = (float)pos[m] * INV_FREQ[f]; ropec[i] = cosf(ang); ropes[i] = sinf(ang); }
    }
    SEAM(0);
    if (PHM(1) && IN(1)) {
        const int gt = gw * 64 + (FRESH_TID() & 63);
        const float* ada_b = LDF(5); const float* modp = (const float*)LDWS(WS_MODP); float* mod = (float*)LDWS(WS_MOD);
        for (int i = gt; i < DEPTH * BATCH * MODW; i += ngt) { const int n = i % MODW, l = i / (BATCH * MODW); float s = 0.f;
#pragma unroll
            for (int kq = 0; kq < 8; ++kq) s += modp[(size_t)kq * DEPTH * BATCH * MODW + i];
            mod[i] = s + ada_b[l * MODW + n]; }
    }
    SEAM(1);
    if (PHM(2) && IN(2)) ln_rows(FRESH_S(gw), ngw, FRESH_LANE(), LDF(0), LDF(6), (const float*)LDWS(WS_MOD), 0, 1, (bf16*)LDWS(WS_XN), nullptr);
    SEAM(2);

#pragma unroll 1
    for (int l = 0; l < DEPTH; ++l) {
        const int sb = 3 + 8 * l;
        if (PHM(3) && IN(sb + 0)) {
            float* ropec = (float*)LDWS(WS_ROPE);
            pg8::Gemm g{(const bf16*)LDWS(WS_XN), (const bf16*)LDWS(WS_WIN) + (size_t)l * INP * D}; pg8::StaticOrder<INP> S; S.init(G, FRESH_S(bx));
            pg8::EpiInProj E{(bf16*)LDWS(WS_PROJ), (float*)LDWS(WS_SSP), ropec, ropec + (size_t)M * 16};
            _Pragma("unroll 1") for (int rep = 0; rep < DUP_INPROJ; ++rep)
            pg8::gemm_phase<pg8::EpiInProj, pg8::StaticOrder<INP>, true, D, D>(lds, g, S, E, wave);
        }
        SEAM(sb + 0);
        if (PHM(4) && IN(sb + 1)) {
            { float* ropec = (float*)LDWS(WS_ROPE);
              pg8::Gemm g{(const bf16*)LDWS(WS_PROJ) + O_BQ, (const bf16*)LDWS(WS_WUP) + (size_t)l * UPN * UPK}; pg8::StaticOrder<UPN> S; S.init(G, FRESH_S(bx));
              pg8::EpiUp E{(bf16*)LDWS(WS_UPO), (const float*)LDWS(WS_SSP), ropec, ropec + (size_t)M * 16};
              pg8::gemm_phase<pg8::EpiUp, pg8::StaticOrder<UPN>, true, UPK, INP>(lds, g, S, E, wave); }
            const int lane = FRESH_LANE(), gwp = FRESH_S(gw);
            LAS char* vt = (LAS char*)(lds + FRESH_S(wave) * 4096);
            const bf16* PROJ = (const bf16*)LDWS(WS_PROJ); bf16* MIX = (bf16*)LDWS(WS_MIX); const float* mix_gain = LDF(12) + l * D;
            { float* GT = (float*)LDWS(WS_GT); LAS char* kt = (LAS char*)(lds + 32768 + FRESH_S(wave) * 2048);
              _Pragma("unroll 1") for (int rep = 0; rep < DUP_RET; ++rep)
              for (int u = gwp; u < 48 * 16; u += ngw) { const int bh = u >> 4, n = u & 15, b = bh / 6, h = bh % 6;
                  ret_pass1(PROJ + (size_t)b * SEQ * INP, h, n, GT + (size_t)u * 2048, kt, vt, lane); } }
            _Pragma("unroll 1") for (int rep = 0; rep < DUP_DIL; ++rep)
            for (int u = gwp; u < 6144; u += ngw) {
                const int r = u & 15, qb = (u >> 4) & 7, bh = u >> 7, b = bh / 6, h = bh % 6;
                dil_unit(PROJ + (size_t)b * SEQ * INP, MIX + (size_t)b * SEQ * D, h, qb * 256, r, vt, tab + h * 3 * 132, mix_gain + h * 64, lane);
            }
        }
        SEAM(sb + 1);
        if (PHM(5) && IN(sb + 2)) {
            const int lane = FRESH_LANE(), gwp = FRESH_S(gw);
            LAS char* vt = (LAS char*)(lds + FRESH_S(wave) * 4096);
            const bf16* PROJ = (const bf16*)LDWS(WS_PROJ); const bf16* UPO = (const bf16*)LDWS(WS_UPO); bf16* MIX = (bf16*)LDWS(WS_MIX); const float* mix_gain = LDF(12) + l * D;
            _Pragma("unroll 1") for (int rep = 0; rep < DUP_MLA; ++rep)
            for (int u = gwp; u < 32 * 64; u += ngw) {
                const int bh = u >> 6, i64 = u & 63, c8 = i64 >> 3, w = i64 & 7, blk = (w < 4) ? c8 * 4 + w : 63 - (c8 * 4 + (w - 4));
                const int b = bh >> 2, h = bh & 3; const bf16* Ub = UPO + (size_t)b * SEQ * UPN;
                FaSrc S{Ub + h * 96, UPN, Ub + 384 + h * 128, UPN, PROJ + (size_t)b * SEQ * INP + O_BKR, INP, Ub + 384 + h * 128 + 64, UPN};
                fa_unit<6, 4, 0>(S, blk * 32, vt, MIX + (size_t)b * SEQ * D + 384 + h * 64, mix_gain + 384 + h * 64, nullptr, lane);
            }
            { const float* GT = (const float*)LDWS(WS_GT);
              _Pragma("unroll 1") for (int rep = 0; rep < DUP_RET; ++rep)
              for (int u = gwp; u < 48 * 64; u += ngw) { const int bh = u >> 6, n = (u >> 2) & 15, j = u & 3, b = bh / 6, h = bh % 6; const bf16* Pb = PROJ + (size_t)b * SEQ * INP;
                  FaSrc S{Pb + O_CQ + h * 32, INP, Pb + O_CK + h * 32, INP, nullptr, 0, Pb + O_CV + h * 64, INP};
                  ret_pass2(S, n, j, GT + (size_t)bh * 16 * 2048, vt, MIX + (size_t)b * SEQ * D + 640 + h * 64, mix_gain + 640 + h * 64, Pb + O_CG + h * 64, lane); } }
        }
        SEAM(sb + 2);
        if (PHM(6) && IN(sb + 3)) {
            float* out = LDOUT(); const float* x_in = LDF(0);
            pg8::Gemm g{(const bf16*)LDWS(WS_MIX), (const bf16*)LDWS(WS_WOUT) + (size_t)l * D * D}; pg8::StaticOrder<D> S; S.init(G, FRESH_S(bx));
            pg8::EpiRes E{l == 0 ? x_in : (const float*)out, out, (const float*)LDWS(WS_MOD) + (size_t)l * BATCH * MODW + 2 * D};
            pg8::gemm_phase<pg8::EpiRes, pg8::StaticOrder<D>, true, D, D>(lds, g, S, E, wave);
        }
        SEAM(sb + 3);
        if (PHM(7) && IN(sb + 4)) _Pragma("unroll 1") for (int rep = 0; rep < DUP_LN2; ++rep) ln_rows(FRESH_S(gw), ngw, FRESH_LANE(), LDOUT(), LDF(14) + l * D, (const float*)LDWS(WS_MOD) + (size_t)l * BATCH * MODW, 3, 4, (bf16*)LDWS(WS_XN), nullptr);
        SEAM(sb + 4);
        if (PHM(8) && IN(sb + 5)) {
            pg8::Gemm g{(const bf16*)LDWS(WS_XN), (const bf16*)LDWS(WS_WGU) + (size_t)l * GU * D}; pg8::StaticOrder<GU> S; S.init(G, FRESH_S(bx));
            pg8::EpiSwiGLU E{(bf16*)LDWS(WS_PROJ)};
            _Pragma("unroll 1") for (int rep = 0; rep < DUP_GU; ++rep)
            pg8::gemm_phase<pg8::EpiSwiGLU, pg8::StaticOrder<GU>, true, D, D>(lds, g, S, E, wave);
        }
        SEAM(sb + 5);
        if (PHM(9) && IN(sb + 6)) {
            float* out = LDOUT();
            pg8::Gemm g{(const bf16*)LDWS(WS_PROJ), (const bf16*)LDWS(WS_WDN) + (size_t)l * D * FFH}; pg8::StaticOrder<D> S; S.init(G, FRESH_S(bx));
            pg8::EpiRes E{out, out, (const float*)LDWS(WS_MOD) + (size_t)l * BATCH * MODW + 5 * D};
            pg8::gemm_phase<pg8::EpiRes, pg8::StaticOrder<D>, true, FFH, FFH>(lds, g, S, E, wave);
        }
        SEAM(sb + 6);
        if (PHM(10) && IN(sb + 7)) {
            const int lane = FRESH_LANE(), gwp = FRESH_S(gw);
            float* out = LDOUT();
            if (l + 1 < DEPTH) ln_rows(gwp, ngw, lane, out, LDF(6) + (l + 1) * D, (const float*)LDWS(WS_MOD) + (size_t)(l + 1) * BATCH * MODW, 0, 1, (bf16*)LDWS(WS_XN), nullptr);
            else ln_rows(gwp, ngw, lane, out, LDF(18), nullptr, 0, 0, nullptr, out);
        }
        if (sb + 8 < NSTEPS) SEAM(sb + 7);
    }
#undef IN
#undef SEAM
}

extern "C" void kernel_launch(void* const* d_in, const int* in_sizes, int n_in, void* d_out, int out_size, void* d_ws, size_t ws_size, hipStream_t stream) {
    static int grid = 0;
    if (grid == 0) {
        if (n_in != 19 || out_size != M * D || ws_size < WS_END) { fprintf(stderr, "kernel_launch: unexpected shapes (n_in %d out %d ws %zu need %zu)\n", n_in, out_size, ws_size, (size_t)WS_END); grid = -1; return; }
        int dev = 0, cus = 0, per_cu = 0;
        if (hipGetDevice(&dev) != hipSuccess || hipDeviceGetAttribute(&cus, hipDeviceAttributeMultiprocessorCount, dev) != hipSuccess) { grid = -1; return; }
        if (hipFuncSetAttribute((const void*)fwd, hipFuncAttributeMaxDynamicSharedMemorySize, LDS_BYTES) != hipSuccess) { fprintf(stderr, "kernel_launch: hipFuncSetAttribute failed\n"); grid = -1; return; }
        if (hipOccupancyMaxActiveBlocksPerMultiprocessor(&per_cu, (const void*)fwd, NWAVES * 64, LDS_BYTES) != hipSuccess || per_cu < 1) fprintf(stderr, "kernel_launch: occupancy query reports %d\n", per_cu);
        (void)hipGetLastError();
        grid = cus;
    }
    if (grid < 0) return;
    if (hipMemsetAsync((char*)d_ws + WS_CTL, 0, CTL_ZERO_BYTES, stream) != hipSuccess) return;
    Args a{};
    for (int i = 0; i < 19; ++i) a.in[i] = (const float*)d_in[i];
    a.out = (float*)d_out; a.ws = (unsigned char*)d_ws;
    if (MK_N_LAUNCHES == 1) { a.st_lo = 0; a.st_hi = NSTEPS; hipLaunchKernelGGL(fwd, dim3(grid), dim3(NWAVES * 64), LDS_BYTES, stream, a); }
    else for (int s = 0; s < NSTEPS; ++s) { a.st_lo = s; a.st_hi = s + 1; hipLaunchKernelGGL(fwd, dim3(grid), dim3(NWAVES * 64), LDS_BYTES, stream, a); }
    const hipError_t le = hipPeekAtLastError();
    if (le != hipSuccess) fprintf(stderr, "kernel_launch: launch failed: %s\n", hipGetErrorName(le));
}
```

```cpp
#include <hip/hip_runtime.h>
#include <cstdio>
#include <cstdint>
#include <cmath>

#define LAS __attribute__((address_space(3)))
#define GAS __attribute__((address_space(1)))
#ifndef MK_N_LAUNCHES
#define MK_N_LAUNCHES 1
#endif

typedef unsigned short bf16;
#define FRESH_LANE() ({ int l_; asm volatile("v_mbcnt_lo_u32_b32 %0, -1, 0\n\tv_mbcnt_hi_u32_b32 %0, -1, %0" : "=v"(l_)); l_; })
typedef short bf16x8 __attribute__((ext_vector_type(8)));
typedef short s16x4 __attribute__((ext_vector_type(4)));
typedef float f32x2 __attribute__((ext_vector_type(2)));
typedef float f32x4 __attribute__((ext_vector_type(4)));
typedef float f32x16 __attribute__((ext_vector_type(16)));
typedef unsigned u32x2 __attribute__((ext_vector_type(2)));
typedef unsigned u32x4 __attribute__((ext_vector_type(4)));

constexpr int D = 1024, BATCH = 8, SEQ = 2048, DEPTH = 4, M = BATCH * SEQ;
constexpr int INW = 2720, INP = 2816, FFH = 2816, GU = 2 * FFH, UPK = 384, UPN = 1024, MODW = 6 * D;
constexpr int O_AQ = 0, O_AK = 384, O_AV = 768, O_BQ = 1152, O_BKR = 1536, O_CQ = 1568, O_CK = 1760, O_CV = 1952, O_CG = 2336;
constexpr float EPS = 1e-6f, LOG2E = 1.4426950408889634f;
constexpr float NEG_INF = -__builtin_huge_valf();

__device__ const unsigned char BUCKET[3][129] = {
 {0, 1, 2, 3, 4, 5, 6, 7, 8, 9, 10, 11, 12, 13, 14, 15, 16, 16, 16, 16, 16, 16, 17, 17, 17, 17, 17, 17, 17, 17, 18, 18, 18, 18, 18, 18, 18, 18, 18, 18, 19, 19, 19, 19, 19, 19, 19, 19, 19, 19, 19, 19, 19, 19, 20, 20, 20, 20, 20, 20, 20, 20, 20, 20, 20, 20, 20, 20, 20, 20, 20, 20, 20, 21, 21, 21, 21, 21, 21, 21, 21, 21, 21, 21, 21, 21, 21, 21, 21, 21, 21, 21, 21, 21, 21, 21, 21, 21, 21, 22, 22, 22, 22, 22, 22, 22, 22, 22, 22, 22, 22, 22, 22, 22, 22, 22, 22, 22, 22, 22, 22, 22, 22, 22, 22, 22, 22, 22, 22},
 {0, 4, 8, 12, 16, 16, 17, 17, 18, 18, 19, 19, 19, 19, 20, 20, 20, 20, 20, 21, 21, 21, 21, 21, 21, 22, 22, 22, 22, 22, 22, 22, 22, 22, 23, 23, 23, 23, 23, 23, 23, 23, 23, 23, 23, 23, 24, 24, 24, 24, 24, 24, 24, 24, 24, 24, 24, 24, 24, 24, 24, 24, 25, 25, 25, 25, 25, 25, 25, 25, 25, 25, 25, 25, 25, 25, 25, 25, 25, 25, 25, 25, 25, 26, 26, 26, 26, 26, 26, 26, 26, 26, 26, 26, 26, 26, 26, 26, 26, 26, 26, 26, 26, 26, 26, 26, 26, 26, 26, 26, 26, 26, 26, 27, 27, 27, 27, 27, 27, 27, 27, 27, 27, 27, 27, 27, 27, 27, 27},
 {0, 16, 18, 19, 20, 21, 21, 22, 22, 23, 23, 23, 24, 24, 24, 24, 25, 25, 25, 25, 25, 26, 26, 26, 26, 26, 26, 26, 26, 27, 27, 27, 27, 27, 27, 27, 27, 27, 27, 28, 28, 28, 28, 28, 28, 28, 28, 28, 28, 28, 28, 28, 29, 29, 29, 29, 29, 29, 29, 29, 29, 29, 29, 29, 29, 29, 29, 29, 29, 29, 30, 30, 30, 30, 30, 30, 30, 30, 30, 30, 30, 30, 30, 30, 30, 30, 30, 30, 30, 30, 30, 30, 30, 30, 30, 31, 31, 31, 31, 31, 31, 31, 31, 31, 31, 31, 31, 31, 31, 31, 31, 31, 31, 31, 31, 31, 31, 31, 31, 31, 31, 31, 31, 31, 31, 31, 31, 31, 31}};
__device__ const float INV_FREQ[16] = {0x1.0000000000000p+0f, 0x1.1feb340000000p-1f, 0x1.43d1360000000p-2f, 0x1.6c310e0000000p-3f, 0x1.99999a0000000p-4f, 0x1.ccab840000000p-5f, 0x1.030dc60000000p-5f, 0x1.235a720000000p-6f, 0x1.47ae140000000p-7f, 0x1.7089380000000p-8f, 0x1.9e7c700000000p-9f, 0x1.d22a500000000p-10f, 0x1.0624de0000000p-10f, 0x1.26d42c0000000p-11f, 0x1.4b96c00000000p-12f, 0x1.74eea60000000p-13f};
__device__ const float LOG_G[6] = {-0x1.0415d80000000p-5f, -0x1.0205660000000p-6f, -0x1.0101580000000p-7f, -0x1.0080560000000p-8f, -0x1.0040160000000p-9f, -0x1.0020060000000p-10f};

__device__ __forceinline__ unsigned cvtpk(float lo, float hi) { typedef __bf16 b2 __attribute__((ext_vector_type(2))); f32x2 v = {lo, hi}; b2 b = __builtin_convertvector(v, b2); return __builtin_bit_cast(unsigned, b); }
__device__ __forceinline__ float bf2f(unsigned short b) { return __uint_as_float((unsigned)b << 16); }
__device__ __forceinline__ float ex2(float x) { return __builtin_amdgcn_exp2f(x); }
__device__ __forceinline__ float silu_fast(float v) { return v * __builtin_amdgcn_rcpf(1.f + ex2(-v * LOG2E)); }
__device__ __forceinline__ float wave_sum(float v) {
#pragma unroll
    for (int o = 1; o < 64; o <<= 1) v += __shfl_xor(v, o);
    return v;
}
__device__ __forceinline__ float xmax32(float v) { auto r = __builtin_amdgcn_permlane32_swap(__float_as_uint(v), __float_as_uint(v), false, false); return fmaxf(__uint_as_float(r[0]), __uint_as_float(r[1])); }
__device__ __forceinline__ float xsum32(float v) { auto r = __builtin_amdgcn_permlane32_swap(__float_as_uint(v), __float_as_uint(v), false, false); return __uint_as_float(r[0]) + __uint_as_float(r[1]); }
__device__ __forceinline__ float xmax16(float v) { auto r = __builtin_amdgcn_permlane16_swap(__float_as_uint(v), __float_as_uint(v), false, false); return fmaxf(__uint_as_float(r[0]), __uint_as_float(r[1])); }
__device__ __forceinline__ float xsum16(float v) { auto r = __builtin_amdgcn_permlane16_swap(__float_as_uint(v), __float_as_uint(v), false, false); return __uint_as_float(r[0]) + __uint_as_float(r[1]); }
__device__ __forceinline__ int crow(int r, int hi) { return (r & 3) + 8 * (r >> 2) + 4 * hi; }
typedef short v4i16_t __attribute__((ext_vector_type(4)));
__device__ __forceinline__ s16x4 trrd(const LAS char* p) { return __builtin_bit_cast(s16x4, __builtin_amdgcn_ds_read_tr16_b64_v4i16((LAS v4i16_t*)p)); }

namespace pg8 {
typedef unsigned short bf16_t;
constexpr int BM = 256, BK = 64, HALF = 128, HTB = HALF * BK * 2, STAGE_BYTES = 8 * HTB, NXCD = 8, WGM = 8;
__host__ __device__ __forceinline__ int lds_byte(int r, int c) { const int st = (r >> 4) * 2 + (c >> 5), rr = r & 15, cc = c & 31, ob = rr * 64 + cc * 2; return st * 1024 + (ob ^ (((ob >> 9) & 1) << 5)); }
__host__ __device__ __forceinline__ void stage_rc(int b, int& R, int& C) { const int st = b / 1024, sb = b % 1024, swz = sb ^ (((sb >> 9) & 1) << 5); R = (st >> 1) * 16 + swz / 64; C = (st & 1) * 32 + (swz % 64) / 2; }
__host__ __device__ __forceinline__ int perm32(int rho) { const int n = rho >> 4, i = rho & 15; return 8 * (i >> 2) + 4 * n + (i & 3); }
struct Unit { int pm, pn; };
struct Gemm { const bf16_t* A; const bf16_t* Bt; };
template <int N_>
struct StaticOrder {
    static constexpr int nM = 64, nN = N_ / BM, nwg = nM * nN;
    int G, c;
    __host__ __device__ void init(int G_, int c_) { G = G_; c = c_; }
    __host__ __device__ bool next(int i, Unit& u) const {
        const long L = (long)i * G + c; if (L >= nwg) return false;
        int wgid = (int)L; { const int q = nwg / NXCD, r = nwg % NXCD, xcd = wgid % NXCD, off = wgid / NXCD; wgid = (xcd < r ? xcd * (q + 1) : r * (q + 1) + (xcd - r) * q) + off; }
        const int nig = WGM * nN, gid = wgid / nig, fm = gid * WGM, gsz = (nM - fm) < WGM ? (nM - fm) : WGM;
        u.pm = fm + ((wgid % nig) % gsz); u.pn = (wgid % nig) / gsz; return true;
    }
};

template <class Epi, class Sched, bool ALIGN_EPI, int K, int lda>
__device__ __forceinline__ void gemm_phase(LAS unsigned char* lds, const Gemm g, const Sched& S, const Epi& E, const int wid_in) {
    int wid = wid_in; asm volatile("" : "+s"(wid));
    const int lane = FRESH_LANE(), tid = wid * 64 + lane;
    const int wr = wid >> 2, wc = wid & 3, fr = lane & 15, fq = lane >> 4;
    constexpr int nt = K / BK;
    unsigned voffA[2], voffB[2];
#pragma unroll
    for (int i = 0; i < 2; ++i) { int R, C; stage_rc(tid * 16 + i * 8192, R, C); const int Rb = Epi::PERM ? ((R & ~31) + perm32(R & 31)) : R;
        voffA[i] = (unsigned)(R * lda + C) * 2u; voffB[i] = (unsigned)(Rb * K + C) * 2u; }
    constexpr size_t kstep = (size_t)(BK * 2);
    constexpr size_t hstepA = (size_t)HALF * lda * 2, hstepB = (size_t)HALF * K * 2;
    constexpr size_t tstepA = 2 * hstepA, tstepB = 2 * hstepB;
    const unsigned ldsw = (unsigned)wid * 1024u;
    const int aoff = lds_byte(wr * 64 + fr, fq * 8), boff = lds_byte(wc * 32 + fr, fq * 8);
#define PG8_SA(b, h) (((b) * 2 + (h)) * HTB)
#define PG8_SB(b, h) ((4 + (b) * 2 + (h)) * HTB)
#define PG8_STAGE(bufoff, gbase, voff) do { _Pragma("unroll") for (int _i = 0; _i < 2; ++_i) \
        __builtin_amdgcn_global_load_lds((const unsigned*)((const char*)(gbase) + (voff)[_i]), (LAS unsigned*)(lds + (bufoff) + ldsw + _i * 8192), 16, 0, 0); } while (0)
#define PG8_LDA(dst, b, h) do { _Pragma("unroll") for (int m = 0; m < 4; ++m) _Pragma("unroll") for (int k = 0; k < 2; ++k) dst[m][k] = *(const LAS bf16x8*)(lds + PG8_SA(b, h) + aoff + m * 2048 + k * 1024); } while (0)
#define PG8_LDB(dst, b, h) do { _Pragma("unroll") for (int n = 0; n < 2; ++n) _Pragma("unroll") for (int k = 0; k < 2; ++k) dst[n][k] = *(const LAS bf16x8*)(lds + PG8_SB(b, h) + boff + n * 2048 + k * 1024); } while (0)
#define PG8_MMA(ai, bj, At, Bt) do { __builtin_amdgcn_s_setprio(1); _Pragma("unroll") for (int m = 0; m < 4; ++m) _Pragma("unroll") for (int n = 0; n < 2; ++n) _Pragma("unroll") for (int k = 0; k < 2; ++k) \
        acc[ai][bj][m][n] = __builtin_amdgcn_mfma_f32_16x16x32_bf16(Bt[n][k], At[m][k], acc[ai][bj][m][n], 0, 0, 0); __builtin_amdgcn_s_setprio(0); } while (0)
#define PG8_WAIT_V(n) asm volatile("s_waitcnt vmcnt(" #n ")" ::: "memory")
#define PG8_WAIT_L(n) asm volatile("s_waitcnt lgkmcnt(" #n ")" ::: "memory")
#define PG8_BAR __builtin_amdgcn_s_barrier()
#define PG8_SCHED __builtin_amdgcn_sched_barrier(0)
    Unit cur, nxt; int ui = 0;
    if (!S.next(0, cur)) return;
    f32x4 acc[2][2][4][2];
#pragma unroll
    for (int a = 0; a < 2; ++a)
#pragma unroll
        for (int b = 0; b < 2; ++b)
#pragma unroll
            for (int m = 0; m < 4; ++m)
#pragma unroll
                for (int n = 0; n < 2; ++n) acc[a][b][m][n] = (f32x4){0.f, 0.f, 0.f, 0.f};
    bf16x8 At[4][2], B0[2][2], B1[2][2];
    const char* cA = (const char*)g.A + (size_t)cur.pm * tstepA; const char* cB = (const char*)g.Bt + (size_t)cur.pn * tstepB;
    PG8_STAGE(PG8_SB(0, 0), cB, voffB); PG8_STAGE(PG8_SB(0, 1), cB + hstepB, voffB); PG8_STAGE(PG8_SA(0, 0), cA, voffA); PG8_STAGE(PG8_SA(0, 1), cA + hstepA, voffA);
    if (wr == 1) PG8_BAR;
    PG8_WAIT_V(2); PG8_BAR;
    PG8_STAGE(PG8_SB(1, 0), cB + kstep, voffB); PG8_STAGE(PG8_SA(1, 0), cA + kstep, voffA); PG8_STAGE(PG8_SB(1, 1), cB + hstepB + kstep, voffB);
    PG8_WAIT_V(6); PG8_BAR;
    for (;;) {
        const bool has_next = S.next(ui + 1, nxt);
        const char* nA = has_next ? (const char*)g.A + (size_t)nxt.pm * tstepA : cA; const char* nB = has_next ? (const char*)g.Bt + (size_t)nxt.pn * tstepB : cB;
        for (int t = 0; t < nt; t += 2) {
            const bool last = (t == nt - 2);
            const char* a1 = cA + (size_t)(t + 1) * kstep;
            const char* a2 = last ? nA : cA + (size_t)(t + 2) * kstep; const char* b2 = last ? nB : cB + (size_t)(t + 2) * kstep;
            const char* a3 = a2 + kstep; const char* b3 = b2 + kstep;
            PG8_LDB(B0, 0, 0); PG8_LDB(B1, 0, 1); PG8_SCHED; PG8_LDA(At, 0, 0); PG8_STAGE(PG8_SA(1, 1), a1 + hstepA, voffA);
            PG8_WAIT_V(8); PG8_WAIT_L(0); PG8_BAR; PG8_MMA(0, 0, At, B0); PG8_MMA(0, 1, At, B1); PG8_BAR; PG8_SCHED;
            PG8_LDA(At, 0, 1); PG8_STAGE(PG8_SB(0, 0), b2, voffB); PG8_STAGE(PG8_SB(0, 1), b2 + hstepB, voffB); PG8_STAGE(PG8_SA(0, 0), a2, voffA);
            PG8_WAIT_V(8); PG8_WAIT_L(0); PG8_BAR; PG8_MMA(1, 0, At, B0); PG8_MMA(1, 1, At, B1); PG8_BAR; PG8_SCHED;
            PG8_LDB(B0, 1, 0); PG8_LDB(B1, 1, 1); PG8_SCHED; PG8_LDA(At, 1, 0); PG8_STAGE(PG8_SA(0, 1), a2 + hstepA, voffA);
            PG8_WAIT_V(8); PG8_WAIT_L(0); PG8_BAR; PG8_MMA(0, 0, At, B0); PG8_MMA(0, 1, At, B1); PG8_BAR; PG8_SCHED;
            PG8_LDA(At, 1, 1); PG8_STAGE(PG8_SB(1, 0), b3, voffB); PG8_STAGE(PG8_SB(1, 1), b3 + hstepB, voffB); PG8_STAGE(PG8_SA(1, 0), a3, voffA);
            PG8_WAIT_V(8); PG8_WAIT_L(0); PG8_BAR; PG8_MMA(1, 0, At, B0); PG8_MMA(1, 1, At, B1); PG8_BAR; PG8_SCHED;
        }
        if constexpr (ALIGN_EPI) { if (wr == 0) PG8_BAR; }
        E(acc, cur, wr, wc, fr, fq);
        if (!has_next) break;
#pragma unroll
        for (int a = 0; a < 2; ++a)
#pragma unroll
            for (int b = 0; b < 2; ++b)
#pragma unroll
                for (int m = 0; m < 4; ++m)
#pragma unroll
                    for (int n = 0; n < 2; ++n) acc[a][b][m][n] = (f32x4){0.f, 0.f, 0.f, 0.f};
        cur = nxt; cA = nA; cB = nB; ++ui;
        if constexpr (ALIGN_EPI) { if (wr == 1) PG8_BAR; }
    }
    PG8_WAIT_V(0);
    if constexpr (!ALIGN_EPI) { if (wr == 0) PG8_BAR; }
    PG8_BAR;
#undef PG8_SA
#undef PG8_SB
#undef PG8_STAGE
#undef PG8_LDA
#undef PG8_LDB
#undef PG8_MMA
#undef PG8_WAIT_V
#undef PG8_WAIT_L
#undef PG8_BAR
#undef PG8_SCHED
}

__device__ __forceinline__ void rope8(f32x4& v0, f32x4& v1, const float* ropec, const float* ropes, int row, int fq) {
    f32x4 p0, p1;
#pragma unroll
    for (int j = 0; j < 4; ++j) { p0[j] = __shfl_xor(v0[j], 32); p1[j] = __shfl_xor(v1[j], 32); }
    const float* cr = ropec + (size_t)row * 16 + 8 * (fq & 1); const float* sr = ropes + (size_t)row * 16 + 8 * (fq & 1);
    const f32x4 c0 = *(const f32x4*)cr, c1 = *(const f32x4*)(cr + 4), s0 = *(const f32x4*)sr, s1 = *(const f32x4*)(sr + 4);
    const float sg = (fq >> 1) ? 1.f : -1.f;
    v0 = v0 * c0 + p0 * s0 * sg; v1 = v1 * c1 + p1 * s1 * sg;
}
__device__ __forceinline__ void store8(bf16_t* p, f32x4 v0, f32x4 v1) { u32x4 w; w.x = cvtpk(v0[0], v0[1]); w.y = cvtpk(v0[2], v0[3]); w.z = cvtpk(v1[0], v1[1]); w.w = cvtpk(v1[2], v1[3]); *(u32x4*)p = w; }

struct EpiInProj {
    static constexpr bool PERM = true;
    bf16_t* O; float* ssp; const float* ropec; const float* ropes;
    __device__ __forceinline__ void operator()(const f32x4 (&acc)[2][2][4][2], const Unit& u, int wr, int wc, int fr, int fq) const {
        { const int ln_ = FRESH_LANE(); fr = ln_ & 15; fq = ln_ >> 4; }
#pragma unroll
        for (int bj = 0; bj < 2; ++bj) {
            const int g = u.pn * 8 + bj * 4 + wc;
            if (g >= 85) continue;
            const int col0 = g * 32 + 8 * fq;
#pragma unroll
            for (int ai = 0; ai < 2; ++ai)
#pragma unroll
                for (int m = 0; m < 4; ++m) {
                    const int row = u.pm * BM + ai * HALF + wr * 64 + m * 16 + fr;
                    f32x4 v0 = acc[ai][bj][m][0], v1 = acc[ai][bj][m][1];
                    if (g < 12) { v0 = v0 * (0.125f * LOG2E); v1 = v1 * (0.125f * LOG2E); }
                    else if (g >= 36 && g < 48) {
                        float ss = (v0[0] * v0[0] + v0[1] * v0[1]) + (v0[2] * v0[2] + v0[3] * v0[3]) + (v1[0] * v1[0] + v1[1] * v1[1]) + (v1[2] * v1[2] + v1[3] * v1[3]);
                        ss += __shfl_xor(ss, 16); ss += __shfl_xor(ss, 32);
                        if (fq == 0) ssp[(size_t)row * 12 + (g - 36)] = ss;
                    } else if (g >= 48 && g < 61) {
                        rope8(v0, v1, ropec, ropes, row, fq);
                        if (g >= 49) {
                            const int t = row & (SEQ - 1); const bool isk = g >= 55; const int hh = isk ? g - 55 : g - 49;
                            const float e = (float)(isk ? 1024 - t : t - 1024) * (LOG_G[hh] * LOG2E);
                            const float sc = ex2(e) * (isk ? 0.17677669529663687f : 1.f);
                            v0 = v0 * sc; v1 = v1 * sc;
                        }
                    }
                    store8(O + (size_t)row * INP + col0, v0, v1);
                    asm volatile("" ::: "memory");
                }
        }
    }
};
struct EpiUp {
    static constexpr bool PERM = true;
    bf16_t* O; const float* ssp; const float* ropec; const float* ropes;
    __device__ __forceinline__ void operator()(const f32x4 (&acc)[2][2][4][2], const Unit& u, int wr, int wc, int fr, int fq) const {
        { const int ln_ = FRESH_LANE(); fr = ln_ & 15; fq = ln_ >> 4; }
#pragma unroll
        for (int ai = 0; ai < 2; ++ai)
#pragma unroll
            for (int m = 0; m < 4; ++m) {
                asm volatile("" ::: "memory");
                const int row = u.pm * BM + ai * HALF + wr * 64 + m * 16 + fr;
                const f32x4 a0 = *(const f32x4*)(ssp + (size_t)row * 12), a1 = *(const f32x4*)(ssp + (size_t)row * 12 + 4), a2 = *(const f32x4*)(ssp + (size_t)row * 12 + 8);
                const float sq = ((a0[0] + a0[1]) + (a0[2] + a0[3])) + ((a1[0] + a1[1]) + (a1[2] + a1[3])), skv = (a2[0] + a2[1]) + (a2[2] + a2[3]);
                const float rq = rsqrtf(sq * (1.f / 256.f) + EPS) * (0.10206207261596575f * LOG2E), rkv = rsqrtf(skv * (1.f / 128.f) + EPS);
#pragma unroll
                for (int bj = 0; bj < 2; ++bj) {
                    const int g = u.pn * 8 + bj * 4 + wc;
                    if (g >= 28) continue;
                    f32x4 v0 = acc[ai][bj][m][0], v1 = acc[ai][bj][m][1];
                    if (g < 12) { if ((g % 3) == 2) rope8(v0, v1, ropec, ropes, row, fq); v0 = v0 * rq; v1 = v1 * rq; }
                    else { v0 = v0 * rkv; v1 = v1 * rkv; }
                    store8(O + (size_t)row * UPN + g * 32 + 8 * fq, v0, v1);
                }
            }
    }
};
struct EpiRes {
    static constexpr bool PERM = false;
    const float* res; float* out; const float* gate;
    __device__ __forceinline__ void operator()(const f32x4 (&acc)[2][2][4][2], const Unit& u, int wr, int wc, int fr, int fq) const {
        { const int ln_ = FRESH_LANE(); fr = ln_ & 15; fq = ln_ >> 4; }
        const int col0 = u.pn * BM + wc * 32 + 4 * fq; const float* gp = gate + (size_t)(u.pm >> 3) * MODW + col0;
        f32x4 gv[2][2];
#pragma unroll
        for (int bj = 0; bj < 2; ++bj)
#pragma unroll
            for (int n = 0; n < 2; ++n) gv[bj][n] = *(const f32x4*)(gp + bj * HALF + n * 16);
#pragma unroll
        for (int ai = 0; ai < 2; ++ai)
#pragma unroll
            for (int m = 0; m < 4; ++m) { const size_t off = (size_t)(u.pm * BM + ai * HALF + wr * 64 + m * 16 + fr) * D + col0;
#pragma unroll
                for (int bj = 0; bj < 2; ++bj)
#pragma unroll
                    for (int n = 0; n < 2; ++n) { const f32x4 r = *(const f32x4*)(res + off + bj * HALF + n * 16); *(f32x4*)(out + off + bj * HALF + n * 16) = r + gv[bj][n] * acc[ai][bj][m][n]; }
                if (m & 1) asm volatile("" ::: "memory"); }
    }
};
struct EpiSwiGLU {
    static constexpr bool PERM = true;
    bf16_t* O;
    __device__ __forceinline__ void operator()(const f32x4 (&acc)[2][2][4][2], const Unit& u, int wr, int wc, int fr, int fq) const {
        { const int ln_ = FRESH_LANE(); fr = ln_ & 15; fq = ln_ >> 4; }
        const int col0 = u.pn * HALF + wc * 32 + 8 * fq;
#pragma unroll
        for (int ai = 0; ai < 2; ++ai)
#pragma unroll
            for (int m = 0; m < 4; ++m) { const int row = u.pm * BM + ai * HALF + wr * 64 + m * 16 + fr;
                f32x4 v0, v1;
#pragma unroll
                for (int j = 0; j < 4; ++j) { v0[j] = silu_fast(acc[ai][0][m][0][j]) * acc[ai][1][m][0][j]; v1[j] = silu_fast(acc[ai][0][m][1][j]) * acc[ai][1][m][1][j]; }
                store8(O + (size_t)row * FFH + col0, v0, v1); }
    }
};
}

__device__ __forceinline__ int vt_chunk_off(int key, int c) { return (c >> 2) * 2048 + key * 64 + (((c & 3) ^ (((key >> 3) & 1) << 1)) << 4); }
__device__ __forceinline__ void vt_stage(LAS char* vt, const u32x4 (&vr)[4], int lane) {
#pragma unroll
    for (int e = 0; e < 4; ++e) *(LAS u32x4*)(vt + vt_chunk_off(8 * e + (lane >> 3), lane & 7)) = vr[e];
}

struct FaSrc { const bf16* q; int ldq; const bf16* k1; int ldk1; const bf16* k2; int ldk2; const bf16* v; int ldv; };
template <int NKS, int NKS1>
__device__ __forceinline__ void fa_load(bf16x8 (&kf)[NKS], u32x4 (&vr)[4], const FaSrc& S, int k0, int lane) {
    const int r = lane & 31, h = lane >> 5;
#pragma unroll
    for (int s = 0; s < NKS; ++s) {
        const bf16* p = (s < NKS1) ? S.k1 + (size_t)(k0 + r) * S.ldk1 + 16 * s + 8 * h : S.k2 + (size_t)(k0 + r) * S.ldk2 + 16 * (s - NKS1) + 8 * h;
        kf[s] = *(const bf16x8*)p; }
#pragma unroll
    for (int e = 0; e < 4; ++e) vr[e] = *(const u32x4*)(S.v + (size_t)(k0 + 8 * e + (lane >> 3)) * S.ldv + 8 * (lane & 7));
}
template <int NKS, bool SOFTMAX>
__device__ __forceinline__ void fa_tile(const bf16x8 (&kf)[NKS], const u32x4 (&vr)[4], const bf16x8 (&qf)[NKS], f32x16 (&O)[2], float& m, float& l, LAS char* vt, int k0, int q0, bool diag, int lane) {
    const int r = lane & 31, h = lane >> 5;
    vt_stage(vt, vr, lane);
    f32x16 S;
#pragma unroll
    for (int i = 0; i < 16; ++i) S[i] = 0.f;
#pragma unroll
    for (int s = 0; s < NKS; ++s) S = __builtin_amdgcn_mfma_f32_32x32x16_bf16(kf[s], qf[s], S, 0, 0, 0);
    if (diag) {
#pragma unroll
        for (int i = 0; i < 16; ++i) if (k0 + crow(i, h) > q0 + r) S[i] = SOFTMAX ? NEG_INF : 0.f;
    }
    if (SOFTMAX) {
        float mx = S[0];
#pragma unroll
        for (int i = 1; i < 16; ++i) mx = fmaxf(mx, S[i]);
        mx = xmax32(mx);
        const float mn = fmaxf(m, mx), ms = (mn == NEG_INF) ? 0.f : mn, alpha = ex2(m - ms);
        m = mn; l *= alpha;
#pragma unroll
        for (int i = 0; i < 16; ++i) { O[0][i] *= alpha; O[1][i] *= alpha; }
        float sum = 0.f;
#pragma unroll
        for (int i = 0; i < 16; ++i) { S[i] = ex2(S[i] - ms); sum += S[i]; }
        l += sum;
    }
    bf16x8 pf[2];
#pragma unroll
    for (int s2 = 0; s2 < 2; ++s2) { u32x4 w; w.x = cvtpk(S[8 * s2 + 0], S[8 * s2 + 1]); w.y = cvtpk(S[8 * s2 + 2], S[8 * s2 + 3]); w.z = cvtpk(S[8 * s2 + 4], S[8 * s2 + 5]); w.w = cvtpk(S[8 * s2 + 6], S[8 * s2 + 7]); pf[s2] = __builtin_bit_cast(bf16x8, w); }
    const int g16 = (lane >> 4) & 1, q = (lane & 15) >> 2, p = lane & 3;
    const int ch = 2 * g16 + (p >> 1);
    const LAS char* blo = vt + (4 * h + q) * 64 + (ch << 4) + (p & 1) * 8;
    const LAS char* bhi = vt + (8 + 4 * h + q) * 64 + ((ch ^ 2) << 4) + (p & 1) * 8;
#pragma unroll
    for (int vb = 0; vb < 2; ++vb)
#pragma unroll
        for (int s2 = 0; s2 < 2; ++s2) {
            const s16x4 lo = trrd(blo + vb * 2048 + s2 * 1024), hi = trrd(bhi + vb * 2048 + s2 * 1024);
            const bf16x8 vf = {lo[0], lo[1], lo[2], lo[3], hi[0], hi[1], hi[2], hi[3]};
            O[vb] = __builtin_amdgcn_mfma_f32_32x32x16_bf16(vf, pf[s2], O[vb], 0, 0, 0);
        }
}
template <int NKS, int NKS1, int MODE>
__device__ __forceinline__ void fa_unit(const FaSrc& S, int q0, LAS char* vt, bf16* mixrow0  , const float* gain, const bf16* gate  , int lane) {
    const int r = lane & 31, h = lane >> 5;
    bf16x8 qf[NKS];
#pragma unroll
    for (int s = 0; s < NKS; ++s) qf[s] = *(const bf16x8*)(S.q + (size_t)(q0 + r) * S.ldq + 16 * s + 8 * h);
    f32x16 O[2];
#pragma unroll
    for (int i = 0; i < 16; ++i) { O[0][i] = 0.f; O[1][i] = 0.f; }
    float m = NEG_INF, l = 0.f;
    const int nt = q0 / 32 + 1;
    bf16x8 kfA[NKS], kfB[NKS]; u32x4 vrA[4], vrB[4];
    fa_load<NKS, NKS1>(kfA, vrA, S, 0, lane);
    for (int kt = 0; kt < nt; kt += 2) {
        fa_load<NKS, NKS1>(kfB, vrB, S, (kt + 1 < nt ? kt + 1 : nt - 1) * 32, lane);
        fa_tile<NKS, MODE == 0>(kfA, vrA, qf, O, m, l, vt, kt * 32, q0, kt == nt - 1, lane);
        fa_load<NKS, NKS1>(kfA, vrA, S, (kt + 2 < nt ? kt + 2 : nt - 1) * 32, lane);
        if (kt + 1 < nt) fa_tile<NKS, MODE == 0>(kfB, vrB, qf, O, m, l, vt, (kt + 1) * 32, q0, kt + 1 == nt - 1, lane);
    }
    const size_t tok = (size_t)(q0 + r);
    if (MODE == 0) {
        const float lt = xsum32(l), inv = 1.f / lt;
        float ss = 0.f;
#pragma unroll
        for (int vb = 0; vb < 2; ++vb)
#pragma unroll
            for (int i = 0; i < 16; ++i) { O[vb][i] *= inv; ss += O[vb][i] * O[vb][i]; }
        ss = xsum32(ss);
        const float rs = rsqrtf(ss * (1.f / 64.f) + EPS);
#pragma unroll
        for (int vb = 0; vb < 2; ++vb)
#pragma unroll
            for (int g = 0; g < 4; ++g) { const int d0 = 32 * vb + 8 * g + 4 * h; const f32x4 gn = *(const f32x4*)(gain + d0);
                u32x2 w; w.x = cvtpk(O[vb][4 * g] * rs * gn[0], O[vb][4 * g + 1] * rs * gn[1]); w.y = cvtpk(O[vb][4 * g + 2] * rs * gn[2], O[vb][4 * g + 3] * rs * gn[3]);
                *(u32x2*)(mixrow0 + tok * D + d0) = w; }
    } else {
        float su = 0.f;
#pragma unroll
        for (int vb = 0; vb < 2; ++vb)
#pragma unroll
            for (int i = 0; i < 16; ++i) su += O[vb][i];
        su = xsum32(su);
        const float mu = su * (1.f / 64.f); float var = 0.f;
#pragma unroll
        for (int vb = 0; vb < 2; ++vb)
#pragma unroll
            for (int i = 0; i < 16; ++i) { O[vb][i] -= mu; var += O[vb][i] * O[vb][i]; }
        var = xsum32(var);
        const float rs = rsqrtf(var * (1.f / 64.f) + EPS);
#pragma unroll
        for (int vb = 0; vb < 2; ++vb)
#pragma unroll
            for (int g = 0; g < 4; ++g) { const int d0 = 32 * vb + 8 * g + 4 * h; const f32x4 gn = *(const f32x4*)(gain + d0);
                const u32x2 gb = *(const u32x2*)(gate + tok * INP + d0);
                const float g0 = silu_fast(__uint_as_float(gb.x << 16)), g1 = silu_fast(__uint_as_float(gb.x & 0xffff0000u)), g2 = silu_fast(__uint_as_float(gb.y << 16)), g3 = silu_fast(__uint_as_float(gb.y & 0xffff0000u));
                u32x2 w; w.x = cvtpk(O[vb][4 * g] * rs * gn[0] * g0, O[vb][4 * g + 1] * rs * gn[1] * g1); w.y = cvtpk(O[vb][4 * g + 2] * rs * gn[2] * g2, O[vb][4 * g + 3] * rs * gn[3] * g3);
                *(u32x2*)(mixrow0 + tok * D + d0) = w; }
    }
}

__device__ __forceinline__ void ret_pass1(const bf16* Pb  , int h, int n, float* GTu  , LAS char* kt, LAS char* vt, int lane) {
    const int q4 = lane >> 4, q = (lane & 15) >> 2, pp = lane & 3, sw = (q4 & 1) << 1;
    f32x4 acc[2][4];
#pragma unroll
    for (int mb = 0; mb < 2; ++mb)
#pragma unroll
        for (int nb = 0; nb < 4; ++nb) acc[mb][nb] = (f32x4){0.f, 0.f, 0.f, 0.f};
    const bf16* kp = Pb + (size_t)(128 * n) * INP + O_CK + h * 32; const bf16* vp = Pb + (size_t)(128 * n) * INP + O_CV + h * 64;
    u32x4 kr[2], vr[4];
#pragma unroll
    for (int e = 0; e < 2; ++e) kr[e] = *(const u32x4*)(kp + (size_t)(16 * e + (lane >> 2)) * INP + 8 * (lane & 3));
#pragma unroll
    for (int e = 0; e < 4; ++e) vr[e] = *(const u32x4*)(vp + (size_t)(8 * e + (lane >> 3)) * INP + 8 * (lane & 7));
#pragma unroll 1
    for (int st = 0; st < 4; ++st) {
#pragma unroll
        for (int e = 0; e < 2; ++e) *(LAS u32x4*)(kt + vt_chunk_off(16 * e + (lane >> 2), lane & 3)) = kr[e];
        vt_stage(vt, vr, lane);
        const int nx = st < 3 ? st + 1 : 3;
#pragma unroll
        for (int e = 0; e < 2; ++e) kr[e] = *(const u32x4*)(kp + (size_t)(32 * nx + 16 * e + (lane >> 2)) * INP + 8 * (lane & 3));
#pragma unroll
        for (int e = 0; e < 4; ++e) vr[e] = *(const u32x4*)(vp + (size_t)(32 * nx + 8 * e + (lane >> 3)) * INP + 8 * (lane & 7));
        const LAS char* kbase = kt + (8 * q4 + q) * 64 + (pp & 1) * 8; const LAS char* vbase = vt + (8 * q4 + q) * 64 + (pp & 1) * 8;
        bf16x8 af[2], bfr[4];
#pragma unroll
        for (int mb = 0; mb < 2; ++mb) { const LAS char* pa = kbase + (((2 * mb + (pp >> 1)) ^ sw) << 4); const s16x4 lo = trrd(pa), hi = trrd(pa + 256); af[mb] = (bf16x8){lo[0], lo[1], lo[2], lo[3], hi[0], hi[1], hi[2], hi[3]}; }
#pragma unroll
        for (int nb = 0; nb < 4; ++nb) { const LAS char* pa = vbase + (nb >> 1) * 2048 + (((2 * (nb & 1) + (pp >> 1)) ^ sw) << 4); const s16x4 lo = trrd(pa), hi = trrd(pa + 256); bfr[nb] = (bf16x8){lo[0], lo[1], lo[2], lo[3], hi[0], hi[1], hi[2], hi[3]}; }
#pragma unroll
        for (int mb = 0; mb < 2; ++mb)
#pragma unroll
            for (int nb = 0; nb < 4; ++nb) acc[mb][nb] = __builtin_amdgcn_mfma_f32_16x16x32_bf16(af[mb], bfr[nb], acc[mb][nb], 0, 0, 0);
    }
#pragma unroll
    for (int mb = 0; mb < 2; ++mb)
#pragma unroll
        for (int nb = 0; nb < 4; ++nb) *(f32x4*)(GTu + (16 * nb + (lane & 15)) * 32 + 16 * mb + 4 * q4) = acc[mb][nb];
}
__device__ __forceinline__ void ret_pass2(const FaSrc& S, int n, int j, const float* GTbh  , LAS char* vt, bf16* mixrow0, const float* gain, const bf16* gate, int lane) {
    const int r = lane & 31, h = lane >> 5, q0 = 128 * n + 32 * j;
    bf16x8 qf[2];
#pragma unroll
    for (int s = 0; s < 2; ++s) qf[s] = *(const bf16x8*)(S.q + (size_t)(q0 + r) * S.ldq + 16 * s + 8 * h);
    f32x16 O[2];
#pragma unroll
    for (int i = 0; i < 16; ++i) { O[0][i] = 0.f; O[1][i] = 0.f; }
    float m = 0.f, l = 0.f;
    bf16x8 kfA[2], kfB[2]; u32x4 vrA[4], vrB[4];
    const int t0 = 4 * n, nt = j + 1;
    fa_load<2, 2>(kfA, vrA, S, t0 * 32, lane);
    f32x4 ff[2][2][2];
#pragma unroll
    for (int vb = 0; vb < 2; ++vb)
#pragma unroll
        for (int s = 0; s < 2; ++s) { ff[vb][s][0] = (f32x4){0.f, 0.f, 0.f, 0.f}; ff[vb][s][1] = (f32x4){0.f, 0.f, 0.f, 0.f}; }
#pragma unroll 1
    for (int mc = 0; mc < n; mc += 2) {
        const float* gp = GTbh + (size_t)mc * 2048 + (size_t)r * 32 + 8 * h;
        const bool two = mc + 1 < n; const float* gq = two ? gp + 2048 : gp; const float w2 = two ? 1.f : 0.f;
        f32x4 t0[2][2][2], t1[2][2][2];
#pragma unroll
        for (int vb = 0; vb < 2; ++vb)
#pragma unroll
            for (int s = 0; s < 2; ++s) { t0[vb][s][0] = *(const f32x4*)(gp + vb * 1024 + 16 * s); t0[vb][s][1] = *(const f32x4*)(gp + vb * 1024 + 16 * s + 4);
                                          t1[vb][s][0] = *(const f32x4*)(gq + vb * 1024 + 16 * s); t1[vb][s][1] = *(const f32x4*)(gq + vb * 1024 + 16 * s + 4); }
#pragma unroll
        for (int vb = 0; vb < 2; ++vb)
#pragma unroll
            for (int s = 0; s < 2; ++s) { ff[vb][s][0] += t0[vb][s][0] + t1[vb][s][0] * w2; ff[vb][s][1] += t0[vb][s][1] + t1[vb][s][1] * w2; }
    }
#pragma unroll
    for (int vb = 0; vb < 2; ++vb)
#pragma unroll
        for (int s = 0; s < 2; ++s) { u32x4 w; w.x = cvtpk(ff[vb][s][0][0], ff[vb][s][0][1]); w.y = cvtpk(ff[vb][s][0][2], ff[vb][s][0][3]); w.z = cvtpk(ff[vb][s][1][0], ff[vb][s][1][1]); w.w = cvtpk(ff[vb][s][1][2], ff[vb][s][1][3]);
            O[vb] = __builtin_amdgcn_mfma_f32_32x32x16_bf16(__builtin_bit_cast(bf16x8, w), qf[s], O[vb], 0, 0, 0); }
    for (int kt = 0; kt < nt; kt += 2) {
        fa_load<2, 2>(kfB, vrB, S, (t0 + (kt + 1 < nt ? kt + 1 : nt - 1)) * 32, lane);
        fa_tile<2, false>(kfA, vrA, qf, O, m, l, vt, (t0 + kt) * 32, q0, kt == nt - 1, lane);
        fa_load<2, 2>(kfA, vrA, S, (t0 + (kt + 2 < nt ? kt + 2 : nt - 1)) * 32, lane);
        if (kt + 1 < nt) fa_tile<2, false>(kfB, vrB, qf, O, m, l, vt, (t0 + kt + 1) * 32, q0, kt + 1 == nt - 1, lane);
    }
    const size_t tok = (size_t)(q0 + r);
    float su = 0.f;
#pragma unroll
    for (int vb = 0; vb < 2; ++vb)
#pragma unroll
        for (int i = 0; i < 16; ++i) su += O[vb][i];
    su = xsum32(su);
    const float mu = su * (1.f / 64.f); float var = 0.f;
#pragma unroll
    for (int vb = 0; vb < 2; ++vb)
#pragma unroll
        for (int i = 0; i < 16; ++i) { O[vb][i] -= mu; var += O[vb][i] * O[vb][i]; }
    var = xsum32(var);
    const float rs = rsqrtf(var * (1.f / 64.f) + EPS);
#pragma unroll
    for (int vb = 0; vb < 2; ++vb)
#pragma unroll
        for (int g = 0; g < 4; ++g) { const int d0 = 32 * vb + 8 * g + 4 * h; const f32x4 gn = *(const f32x4*)(gain + d0);
            const u32x2 gb = *(const u32x2*)(gate + tok * INP + d0);
            const float g0 = silu_fast(__uint_as_float(gb.x << 16)), g1 = silu_fast(__uint_as_float(gb.x & 0xffff0000u)), g2 = silu_fast(__uint_as_float(gb.y << 16)), g3 = silu_fast(__uint_as_float(gb.y & 0xffff0000u));
            u32x2 w; w.x = cvtpk(O[vb][4 * g] * rs * gn[0] * g0, O[vb][4 * g + 1] * rs * gn[1] * g1); w.y = cvtpk(O[vb][4 * g + 2] * rs * gn[2] * g2, O[vb][4 * g + 3] * rs * gn[3] * g3);
            *(u32x2*)(mixrow0 + tok * D + d0) = w; }
}

__device__ __forceinline__ void dil_params(int si, int n3, int n2, int s2s, int s1s, int T0, int r, int& kb, int& sh, int& p) {
    if (si < n3) { p = 2; sh = 4; kb = 512 * si + r; }
    else if (si < n3 + n2) { const int s = s2s + (si - n3); p = 1; sh = 2; kb = 4 * ((T0 >> 2) + (r >> 2) - 128 + 32 * s) + (r & 3); }
    else { const int s = s1s + (si - n3 - n2); p = 0; sh = 0; kb = T0 - 128 + 32 * s; }
}
__device__ __forceinline__ int clampi(int v, int lo, int hi) { return v < lo ? lo : (v > hi ? hi : v); }
__device__ __forceinline__ void dil_load(bf16x8 (&kf)[2][2], u32x4 (&vr)[4], const bf16* P, int h, int kb, int sh, int lane) {
    const int mrow = lane & 15, q4 = lane >> 4;
#pragma unroll
    for (int a = 0; a < 2; ++a) { const int kk = 8 * (mrow >> 2) + 4 * a + (mrow & 3); const int tk = clampi(kb + (kk << sh), 0, SEQ - 1);
        const bf16* p = P + (size_t)tk * INP + O_AK + h * 64 + 8 * q4;
        kf[a][0] = *(const bf16x8*)p; kf[a][1] = *(const bf16x8*)(p + 32); }
#pragma unroll
    for (int e = 0; e < 4; ++e) { const int kk = 8 * e + (lane >> 3); const int tk = clampi(kb + (kk << sh), 0, SEQ - 1);
        vr[e] = *(const u32x4*)(P + (size_t)tk * INP + O_AV + h * 64 + 8 * (lane & 7)); }
}
__device__ __forceinline__ void dil_step(const bf16x8 (&kf)[2][2], const u32x4 (&vr)[4], bf16x8 qf0, bf16x8 qf1, f32x4 (&O)[4], float& m, float& l, LAS char* vt, const LAS float* tabh, int kb, int sh, int p, int tq, int lane) {
    const int q4 = lane >> 4;
    vt_stage(vt, vr, lane);
    f32x4 S[2];
#pragma unroll
    for (int a = 0; a < 2; ++a) { S[a] = (f32x4){0.f, 0.f, 0.f, 0.f};
        S[a] = __builtin_amdgcn_mfma_f32_16x16x32_bf16(kf[a][0], qf0, S[a], 0, 0, 0);
        S[a] = __builtin_amdgcn_mfma_f32_16x16x32_bf16(kf[a][1], qf1, S[a], 0, 0, 0); }
    const int jq = (tq - kb) >> sh;
    float sc[8];
#pragma unroll
    for (int a = 0; a < 2; ++a)
#pragma unroll
        for (int i = 0; i < 4; ++i) { const int kk = 8 * q4 + 4 * a + i, jidx = jq - kk;
            const bool valid = ((unsigned)jidx <= 128u) && (kb + (kk << sh) >= 0);
            const float b = tabh[p * 132 + clampi(jidx, 0, 128)];
            sc[4 * a + i] = (S[a][i] + b) + (valid ? 0.f : NEG_INF); }
    float mx = sc[0];
#pragma unroll
    for (int i = 1; i < 8; ++i) mx = fmaxf(mx, sc[i]);
    mx = xmax32(xmax16(mx));
    const float mn = fmaxf(m, mx), ms = (mn == NEG_INF) ? 0.f : mn, alpha = ex2(m - ms);
    m = mn; l *= alpha;
#pragma unroll
    for (int db = 0; db < 4; ++db) O[db] = O[db] * alpha;
    float sum = 0.f;
#pragma unroll
    for (int i = 0; i < 8; ++i) { sc[i] = ex2(sc[i] - ms); sum += sc[i]; }
    l += sum;
    u32x4 w; w.x = cvtpk(sc[0], sc[1]); w.y = cvtpk(sc[2], sc[3]); w.z = cvtpk(sc[4], sc[5]); w.w = cvtpk(sc[6], sc[7]);
    const bf16x8 pf = __builtin_bit_cast(bf16x8, w);
    const int q = (lane & 15) >> 2, pp = lane & 3, sw = (q4 & 1) << 1;
    const LAS char* base = vt + (8 * q4 + q) * 64 + (pp & 1) * 8;
#pragma unroll
    for (int db = 0; db < 4; ++db) {
        const int ch = 2 * (db & 1) + (pp >> 1);
        const LAS char* pa = base + (db >> 1) * 2048 + ((ch ^ sw) << 4);
        const s16x4 lo = trrd(pa), hi = trrd(pa + 4 * 64);
        const bf16x8 vf = {lo[0], lo[1], lo[2], lo[3], hi[0], hi[1], hi[2], hi[3]};
        O[db] = __builtin_amdgcn_mfma_f32_16x16x32_bf16(vf, pf, O[db], 0, 0, 0);
    }
}
__device__ __forceinline__ void dil_unit(const bf16* P, bf16* MX, int h, int T0, int r, LAS char* vt, const LAS float* tabh, const float* gain, int lane) {
    const int n = lane & 15, q4 = lane >> 4, tq = T0 + 16 * n + r;
    const bf16* qp = P + (size_t)tq * INP + O_AQ + h * 64 + 8 * q4;
    const bf16x8 qf0 = *(const bf16x8*)qp, qf1 = *(const bf16x8*)(qp + 32);
    f32x4 O[4];
#pragma unroll
    for (int db = 0; db < 4; ++db) O[db] = (f32x4){0.f, 0.f, 0.f, 0.f};
    float m = NEG_INF, l = 0.f;
    const int n3 = (T0 >> 9) + 1, s2s = (T0 == 0) ? 3 : ((T0 == 256) ? 1 : 0), n2 = 6 - s2s, s1s = (T0 == 0) ? 4 : 0, ns = n3 + n2 + 12 - s1s;
    bf16x8 kfA[2][2], kfB[2][2]; u32x4 vrA[4], vrB[4];
    int kbA, shA, pA, kbB = 0, shB = 0, pB = 0;
    dil_params(0, n3, n2, s2s, s1s, T0, r, kbA, shA, pA); dil_load(kfA, vrA, P, h, kbA, shA, lane);
    for (int si = 0; si < ns; si += 2) {
        dil_params(si + 1 < ns ? si + 1 : ns - 1, n3, n2, s2s, s1s, T0, r, kbB, shB, pB); dil_load(kfB, vrB, P, h, kbB, shB, lane);
        dil_step(kfA, vrA, qf0, qf1, O, m, l, vt, tabh, kbA, shA, pA, tq, lane);
        dil_params(si + 2 < ns ? si + 2 : ns - 1, n3, n2, s2s, s1s, T0, r, kbA, shA, pA); dil_load(kfA, vrA, P, h, kbA, shA, lane);
        if (si + 1 < ns) dil_step(kfB, vrB, qf0, qf1, O, m, l, vt, tabh, kbB, shB, pB, tq, lane);
    }
    const float lt = xsum32(xsum16(l));
    const float inv = 1.f / lt; float ss = 0.f;
#pragma unroll
    for (int db = 0; db < 4; ++db) { O[db] = O[db] * inv; ss += (O[db][0] * O[db][0] + O[db][1] * O[db][1]) + (O[db][2] * O[db][2] + O[db][3] * O[db][3]); }
    ss = xsum32(xsum16(ss));
    const float rs = rsqrtf(ss * (1.f / 64.f) + EPS);
#pragma unroll
    for (int db = 0; db < 4; ++db) { const int d0 = 16 * db + 4 * q4; const f32x4 gn = *(const f32x4*)(gain + d0);
        u32x2 w; w.x = cvtpk(O[db][0] * rs * gn[0], O[db][1] * rs * gn[1]); w.y = cvtpk(O[db][2] * rs * gn[2], O[db][3] * rs * gn[3]);
        *(u32x2*)(MX + (size_t)tq * D + h * 64 + d0) = w; }
}

constexpr size_t MiB = 1u << 20;
constexpr size_t WS_CTL = 0, CTL_ZERO_BYTES = 1 * MiB;
constexpr size_t WS_MOD = 1 * MiB, WS_MODP = 2 * MiB, WS_ROPE = 9 * MiB, WS_SSP = 11 * MiB;
constexpr size_t WS_WIN = 12 * MiB, WS_WOUT = 34 * MiB, WS_WGU = 42 * MiB, WS_WDN = 86 * MiB, WS_WUP = 108 * MiB;
constexpr size_t WS_XN = 112 * MiB, WS_MIX = 144 * MiB, WS_UPO = 176 * MiB, WS_PROJ = 208 * MiB, WS_GT = 296 * MiB, WS_END = 304 * MiB;
constexpr int CW_BAR = 4096;
constexpr int RING_BYTES = 131072, LDSCTL_OFF = RING_BYTES, MISC_OFF = LDSCTL_OFF + 320, PTAB_OFF = LDSCTL_OFF + 512, TAB_OFF = LDSCTL_OFF + 768, LDS_BYTES = TAB_OFF + 6 * 3 * 132 * 4 + 64;
static_assert(LDS_BYTES <= 160 * 1024, "LDS");
constexpr int NWAVES = 8;
constexpr int NSTEPS = 3 + 8 * DEPTH;

#define XB_TMO      128
#define XB_XCNT(j)  (256  + 64 * (j))
#define XB_XSUB(j)  (1280 + 64 * (j))
#define XB_XGEN(j)  (2304 + 64 * (j))
#define XB_TOP      3328
#define XB_TOPGEN   3392
#define XCD_BAR_WORDS 3456
#define XB_SPIN_CAP (1u << 18)
typedef GAS unsigned gu32;
__device__ __forceinline__ unsigned xb_ld(gu32* p)              { return __hip_atomic_load(p, __ATOMIC_RELAXED, __HIP_MEMORY_SCOPE_AGENT); }
__device__ __forceinline__ unsigned xb_add(gu32* p, unsigned v) { return __hip_atomic_fetch_add(p, v, __ATOMIC_RELAXED, __HIP_MEMORY_SCOPE_AGENT); }
__device__ __forceinline__ unsigned xb_xcc_id() { return (unsigned)__builtin_amdgcn_s_getreg((3 << 11) | 20) & 0xFu; }
#define XB_SPIN(cond, bar) do { unsigned _sp = 0; while (cond) { __builtin_amdgcn_s_sleep(1); \
    if ((++_sp & 255u) == 0u) { if (xb_ld(&(bar)[XB_TMO])) break; if (_sp > XB_SPIN_CAP) { xb_add(&(bar)[XB_TMO], 1u); break; } } } } while (0)
struct XcdBarrier { unsigned x; volatile LAS unsigned* st; };
__device__ __forceinline__ XcdBarrier xcd_barrier_post(gu32* bar, volatile LAS unsigned* st, bool t0) {
    XcdBarrier b; b.x = xb_xcc_id(); b.st = st;
    if (t0) (void)xb_add(&bar[XB_XCNT(b.x)], 1u);
    return b;
}
__device__ __forceinline__ void xcd_barrier_complete(gu32* bar, unsigned x, unsigned& nloc, unsigned& nx) {
    const unsigned G = gridDim.x * gridDim.y * gridDim.z;
    unsigned sum, cnt, mine, sp = 0u;
    for (;;) {
        sum = 0u; cnt = 0u; mine = 0u;
#pragma unroll
        for (unsigned j = 0; j < 16; ++j) { const unsigned c = xb_ld(&bar[XB_XCNT(j)]); sum += c; cnt += (c > 0u) ? 1u : 0u; mine = (j == x) ? c : mine; }
        if (sum == G) break;
        __builtin_amdgcn_s_sleep(1);
        if ((++sp & 255u) == 0u) { if (xb_ld(&bar[XB_TMO])) break; if (sp > XB_SPIN_CAP) { xb_add(&bar[XB_TMO], 1u); break; } }
    }
    nloc = mine > 0u ? mine : 1u; nx = cnt > 0u ? cnt : 1u;
}
__device__ __forceinline__ void xcd_barrier(const XcdBarrier& b, gu32* bar_, int wave) {
    asm volatile("s_waitcnt vmcnt(0)" ::: "memory");
    __syncthreads();
    if (wave == 0 && FRESH_LANE() == 0) {
        unsigned long long bv_ = (unsigned long long)bar_; asm volatile("" : "+v"(bv_)); gu32* bar = (gu32*)bv_;
        __builtin_amdgcn_s_waitcnt(0);
        unsigned nloc = b.st[0], nx = b.st[1];
        if (nloc == 0u) { xcd_barrier_complete(bar, b.x, nloc, nx); b.st[0] = nloc; b.st[1] = nx; }
        const unsigned old = xb_add(&bar[XB_XSUB(b.x)], 1u);
        const unsigned gen = old / nloc;
        if (old + 1u == (gen + 1u) * nloc) {
            __builtin_amdgcn_fence(__ATOMIC_RELEASE, "agent");
            asm volatile("s_waitcnt vmcnt(0)" ::: "memory");
            const unsigned og = xb_add(&bar[XB_TOP], 1u);
            const unsigned tg = og / nx;
            if (og + 1u == (tg + 1u) * nx) xb_add(&bar[XB_TOPGEN], 1u);
            else XB_SPIN(xb_ld(&bar[XB_TOPGEN]) == tg, bar);
            __builtin_amdgcn_fence(__ATOMIC_ACQUIRE, "agent");
            xb_add(&bar[XB_XGEN(b.x)], 1u);
            asm volatile("s_waitcnt vmcnt(0)" ::: "memory");
        } else {
            XB_SPIN(xb_ld(&bar[XB_XGEN(b.x)]) == gen, bar);
            __builtin_amdgcn_fence(__ATOMIC_ACQUIRE, "agent");
            asm volatile("s_waitcnt vmcnt(0)" ::: "memory");
        }
    }
    __syncthreads();
}

__device__ __forceinline__ void transpose_item(const float* W, int K, int N, bf16* WT, int k0, int n0, int orow0, LAS float* scr, int lane) {
#pragma unroll 8
    for (int i = 0; i < 32; ++i) { const int kk = 2 * i + (lane >> 5); scr[kk * 33 + (lane & 31)] = W[(size_t)(k0 + kk) * N + n0 + (lane & 31)]; }
    asm volatile("s_waitcnt lgkmcnt(0)" ::: "memory");
    const int c = lane & 7;
#pragma unroll
    for (int j = 0; j < 4; ++j) { const int n = (lane >> 3) + 8 * j; const LAS float* s = scr + (8 * c) * 33 + n;
        u32x4 o; o.x = cvtpk(s[0 * 33], s[1 * 33]); o.y = cvtpk(s[2 * 33], s[3 * 33]); o.z = cvtpk(s[4 * 33], s[5 * 33]); o.w = cvtpk(s[6 * 33], s[7 * 33]);
        *(u32x4*)(WT + (size_t)(orow0 + n) * K + k0 + 8 * c) = o; }
    asm volatile("s_waitcnt lgkmcnt(0)" ::: "memory");
}
__device__ __forceinline__ void ln_rows(int gw, int ngw, int lane, const float* xin, const float* g, const float* modl, int ch_sh, int ch_sc, bf16* xn, float* outf) {
    for (int m = gw; m < M; m += ngw) {
        const f32x4* xr = (const f32x4*)(xin + (size_t)m * D) + lane;
        f32x4 v[4]; float s = 0.f;
#pragma unroll
        for (int j = 0; j < 4; ++j) { v[j] = xr[64 * j]; s += (v[j][0] * v[j][0] + v[j][1] * v[j][1]) + (v[j][2] * v[j][2] + v[j][3] * v[j][3]); }
        const float rs = rsqrtf(wave_sum(s) * (1.f / D) + EPS);
        const int b = m / SEQ;
#pragma unroll
        for (int j = 0; j < 4; ++j) { const int n0 = 4 * lane + 256 * j; f32x4 y = v[j] * rs * *(const f32x4*)(g + n0);
            if (modl) { const f32x4 sc = *(const f32x4*)(modl + (size_t)b * MODW + ch_sc * D + n0), sh = *(const f32x4*)(modl + (size_t)b * MODW + ch_sh * D + n0); y = y * (sc + 1.f) + sh; }
            if (xn) { u32x2 w; w.x = cvtpk(y[0], y[1]); w.y = cvtpk(y[2], y[3]); *(u32x2*)(xn + (size_t)m * D + n0) = w; }
            else *(f32x4*)(outf + (size_t)m * D + n0) = y; }
    }
}

struct Args { const float* in[19]; float* out; unsigned char* ws; int st_lo, st_hi; };
__global__ void __launch_bounds__(NWAVES * 64, 2) fwd(Args args) {
    extern __shared__ __attribute__((aligned(16))) unsigned char lds_raw[];
    LAS unsigned char* lds = (LAS unsigned char*)lds_raw;
    volatile LAS unsigned* MISC = (volatile LAS unsigned*)(lds + MISC_OFF);
    const int wave = __builtin_amdgcn_readfirstlane(threadIdx.x >> 6);
    const int G = gridDim.x; const int bx = blockIdx.x; const int vcu = (G % 8 == 0) ? (bx % 8) * (G / 8) + bx / 8 : bx;
    const int gw = vcu * NWAVES + wave, ngw = G * NWAVES, ngt = ngw * 64;
    LAS unsigned long long* ptab = (LAS unsigned long long*)(lds + PTAB_OFF);
    const int tid = wave * 64 + FRESH_LANE();
    if (tid == 0) {
#pragma unroll
        for (int i = 0; i < 19; ++i) ptab[i] = (unsigned long long)args.in[i];
        ptab[19] = (unsigned long long)args.out; ptab[20] = (unsigned long long)args.ws;
    }
#define FRESH_TID() (wave * 64 + FRESH_LANE())
#define FRESH_S(x) ({ int s_ = (x); asm volatile("" : "+s"(s_)); s_; })
#define LDP_RAW(i) ({ const unsigned long long v_ = ptab[i]; const unsigned lo_ = __builtin_amdgcn_readfirstlane((unsigned)v_), hi_ = __builtin_amdgcn_readfirstlane((unsigned)(v_ >> 32)); ((unsigned long long)hi_ << 32) | lo_; })
#define LDF(i) ((const float*)(const GAS float*)LDP_RAW(i))
#define LDWS(off) ((unsigned char*)(GAS unsigned char*)(LDP_RAW(20) + (off)))
#define LDOUT() ((float*)(GAS float*)LDP_RAW(19))
    for (int u = tid; u < (PTAB_OFF - LDSCTL_OFF) / 4; u += NWAVES * 64) ((LAS unsigned*)(lds + LDSCTL_OFF))[u] = 0u;
    LAS float* tab = (LAS float*)(lds + TAB_OFF);
    { const float* rel_bias = args.in[3];
      for (int u = tid; u < 6 * 3 * 129; u += NWAVES * 64) { const int j = u % 129, hp = u / 129, p = hp % 3, h = hp / 3; tab[hp * 132 + j] = rel_bias[BUCKET[p][j] * 6 + h] * LOG2E; } }
    __syncthreads();
    const int lo = args.st_lo, hi = args.st_hi;
    const XcdBarrier bar = xcd_barrier_post((gu32*)(args.ws + WS_CTL) + CW_BAR, MISC + 8, tid == 0);
#ifndef PHASE_MASK
#define PHASE_MASK 0xffff
#endif
#ifndef DUP_RET
#define DUP_RET 1
#endif
#ifndef DUP_DIL
#define DUP_DIL 1
#endif
#ifndef DUP_MLA
#define DUP_MLA 1
#endif
#ifndef DUP_INPROJ
#define DUP_INPROJ 1
#endif
#ifndef DUP_GU
#define DUP_GU 1
#endif
#ifndef DUP_LN2
#define DUP_LN2 1
#endif
#define PHM(b) ((PHASE_MASK >> (b)) & 1)
#define IN(k) (lo <= (k) && (k) < hi)
#define SEAM(k) do { if (IN(k) && IN((k) + 1)) xcd_barrier(bar, (gu32*)(args.ws + WS_CTL) + CW_BAR, wave); } while (0)

    if (PHM(0) && IN(0)) {
        const int tidp = FRESH_TID(), lane = tidp & 63, gt = gw * 64 + lane;
        const float* c_in = LDF(1); const int* pos = (const int*)LDF(2); const float* ada_w = LDF(4); const float* w_in = LDF(7);
        const float* q_norm = LDF(8); const float* kv_norm = LDF(9); const float* w_uq = LDF(10); const float* w_ukv = LDF(11);
        const float* w_out = LDF(13); const float* w_gate = LDF(15); const float* w_up = LDF(16); const float* w_down = LDF(17);
        float* modp = (float*)LDWS(WS_MODP); float* ropec = (float*)LDWS(WS_ROPE); float* ropes = ropec + (size_t)M * 16;
        bf16* Win_t = (bf16*)LDWS(WS_WIN); bf16* Wout_t = (bf16*)LDWS(WS_WOUT); bf16* Wgu_t = (bf16*)LDWS(WS_WGU); bf16* Wdn_t = (bf16*)LDWS(WS_WDN); bf16* Wup_t = (bf16*)LDWS(WS_WUP);
        LAS float* scr = (LAS float*)(lds + wave * 8704);
        LAS float* cact = (LAS float*)(lds + 73728);
        for (int i = tidp; i < BATCH * D; i += NWAVES * 64) { const int b = i / D, k = i % D; const float v = c_in[i]; cact[k * 8 + b] = v / (1.f + expf(-v)); }
        __syncthreads();
        for (int it = gw; it < DEPTH * 96 * 8; it += ngw) {
            const int kq = it & 7, cg = (it >> 3) % 96, l = it / (96 * 8), n = cg * 64 + lane;
            const float* wp = ada_w + ((size_t)l * D + kq * 128) * MODW + n;
            float a[8];
#pragma unroll
            for (int b = 0; b < 8; ++b) a[b] = 0.f;
#pragma unroll 16
            for (int k = 0; k < 128; ++k) { const float wv = wp[(size_t)k * MODW]; const f32x4 c0 = *(const LAS f32x4*)(cact + (kq * 128 + k) * 8), c1 = *(const LAS f32x4*)(cact + (kq * 128 + k) * 8 + 4);
                a[0] += c0[0] * wv; a[1] += c0[1] * wv; a[2] += c0[2] * wv; a[3] += c0[3] * wv; a[4] += c1[0] * wv; a[5] += c1[1] * wv; a[6] += c1[2] * wv; a[7] += c1[3] * wv; }
#pragma unroll
            for (int b = 0; b < 8; ++b) modp[(((size_t)kq * DEPTH + l) * BATCH + b) * MODW + n] = a[b];
        }
        constexpr int I_IN = 16 * 85, I_OUT = 16 * 32, I_G = 16 * 88, I_DN = 44 * 32, I_L = I_IN + I_OUT + 2 * I_G + I_DN;
        for (int it = gw; it < DEPTH * I_L; it += ngw) {
            const int l = it / I_L; int r = it % I_L;
            if (r < I_IN) { const int kb = r / 85, nb = r % 85; transpose_item(w_in + (size_t)l * D * INW, D, INW, Win_t + (size_t)l * INP * D, 64 * kb, 32 * nb, 32 * nb, scr, lane); continue; } r -= I_IN;
            if (r < I_OUT) { const int kb = r / 32, nb = r % 32; transpose_item(w_out + (size_t)l * D * D, D, D, Wout_t + (size_t)l * D * D, 64 * kb, 32 * nb, 32 * nb, scr, lane); continue; } r -= I_OUT;
            if (r < I_G) { const int kb = r / 88, nb = r % 88, n0 = 32 * nb; transpose_item(w_gate + (size_t)l * D * FFH, D, FFH, Wgu_t + (size_t)l * GU * D, 64 * kb, n0, 256 * (n0 >> 7) + (n0 & 127), scr, lane); continue; } r -= I_G;
            if (r < I_G) { const int kb = r / 88, nb = r % 88, n0 = 32 * nb; transpose_item(w_up + (size_t)l * D * FFH, D, FFH, Wgu_t + (size_t)l * GU * D, 64 * kb, n0, 256 * (n0 >> 7) + 128 + (n0 & 127), scr, lane); continue; } r -= I_G;
            { const int kb = r / 32, nb = r % 32; transpose_item(w_down + (size_t)l * FFH * D, FFH, D, Wdn_t + (size_t)l * D * FFH, 64 * kb, 32 * nb, 32 * nb, scr, lane); }
        }
        for (int i = gt; i < DEPTH * 96 * D / 8; i += ngt) { const int l = i / (96 * D / 8), r = i % (96 * D / 8); *(u32x4*)(Win_t + (size_t)l * INP * D + (size_t)INW * D + (size_t)r * 8) = (u32x4){0u, 0u, 0u, 0u}; }
        for (int i = gt; i < DEPTH * UPN * UPK; i += ngt) { const int l = i / (UPN * UPK), rr = i % (UPN * UPK), n = rr / UPK, k = rr % UPK; float v = 0.f;
            if (n < 384) { if (k < 256) v = q_norm[l * 256 + k] * w_uq[((size_t)l * 256 + k) * 384 + n]; }
            else if (n < 896) { if (k >= 256) v = kv_norm[l * 128 + (k - 256)] * w_ukv[((size_t)l * 128 + (k - 256)) * 512 + (n - 384)]; }
            Wup_t[i] = (bf16)(cvtpk(v, 0.f) & 0xffffu); }
        for (int i = gt; i < M * 16; i += ngt) { const int m = i >> 4, f = i & 15; const float ang = (float)pos[m] * INV_FREQ[f]; ropec[i] = cosf(ang); ropes[i] = sinf(ang); }
    }
    SEAM(0);
    if (PHM(1) && IN(1)) {
        const int gt = gw * 64 + (FRESH_TID() & 63);
        const float* ada_b = LDF(5); const float* modp = (const float*)LDWS(WS_MODP); float* mod = (float*)LDWS(WS_MOD);
        for (int i = gt; i < DEPTH * BATCH * MODW; i += ngt) { const int n = i % MODW, l = i / (BATCH * MODW); float s = 0.f;
#pragma unroll
            for (int kq = 0; kq < 8; ++kq) s += modp[(size_t)kq * DEPTH * BATCH * MODW + i];
            mod[i] = s + ada_b[l * MODW + n]; }
    }
    SEAM(1);
    if (PHM(2) && IN(2)) ln_rows(FRESH_S(gw), ngw, FRESH_LANE(), LDF(0), LDF(6), (const float*)LDWS(WS_MOD), 0, 1, (bf16*)LDWS(WS_XN), nullptr);
    SEAM(2);

#pragma unroll 1
    for (int l = 0; l < DEPTH; ++l) {
        const int sb = 3 + 8 * l;
        if (PHM(3) && IN(sb + 0)) {
            float* ropec = (float*)LDWS(WS_ROPE);
            pg8::Gemm g{(const bf16*)LDWS(WS_XN), (const bf16*)LDWS(WS_WIN) + (size_t)l * INP * D}; pg8::StaticOrder<INP> S; S.init(G, FRESH_S(bx));
            pg8::EpiInProj E{(bf16*)LDWS(WS_PROJ), (float*)LDWS(WS_SSP), ropec, ropec + (size_t)M * 16};
            _Pragma("unroll 1") for (int rep = 0; rep < DUP_INPROJ; ++rep)
            pg8::gemm_phase<pg8::EpiInProj, pg8::StaticOrder<INP>, true, D, D>(lds, g, S, E, wave);
        }
        SEAM(sb + 0);
        if (PHM(4) && IN(sb + 1)) {
            { float* ropec = (float*)LDWS(WS_ROPE);
              pg8::Gemm g{(const bf16*)LDWS(WS_PROJ) + O_BQ, (const bf16*)LDWS(WS_WUP) + (size_t)l * UPN * UPK}; pg8::StaticOrder<UPN> S; S.init(G, FRESH_S(bx));
              pg8::EpiUp E{(bf16*)LDWS(WS_UPO), (const float*)LDWS(WS_SSP), ropec, ropec + (size_t)M * 16};
              pg8::gemm_phase<pg8::EpiUp, pg8::StaticOrder<UPN>, true, UPK, INP>(lds, g, S, E, wave); }
            const int lane = FRESH_LANE(), gwp = FRESH_S(gw);
            LAS char* vt = (LAS char*)(lds + FRESH_S(wave) * 4096);
            const bf16* PROJ = (const bf16*)LDWS(WS_PROJ); bf16* MIX = (bf16*)LDWS(WS_MIX); const float* mix_gain = LDF(12) + l * D;
            { float* GT = (float*)LDWS(WS_GT); LAS char* kt = (LAS char*)(lds + 32768 + FRESH_S(wave) * 2048);
              _Pragma("unroll 1") for (int rep = 0; rep < DUP_RET; ++rep)
              for (int u = gwp; u < 48 * 16; u += ngw) { const int bh = u >> 4, n = u & 15, b = bh / 6, h = bh % 6;
                  ret_pass1(PROJ + (size_t)b * SEQ * INP, h, n, GT + (size_t)u * 2048, kt, vt, lane); } }
            _Pragma("unroll 1") for (int rep = 0; rep < DUP_DIL; ++rep)
            for (int u = gwp; u < 6144; u += ngw) {
                const int r = u & 15, qb = (u >> 4) & 7, bh = u >> 7, b = bh / 6, h = bh % 6;
                dil_unit(PROJ + (size_t)b * SEQ * INP, MIX + (size_t)b * SEQ * D, h, qb * 256, r, vt, tab + h * 3 * 132, mix_gain + h * 64, lane);
            }
        }
        SEAM(sb + 1);
        if (PHM(5) && IN(sb + 2)) {
            const int lane = FRESH_LANE(), gwp = FRESH_S(gw);
            LAS char* vt = (LAS char*)(lds + FRESH_S(wave) * 4096);
            const bf16* PROJ = (const bf16*)LDWS(WS_PROJ); const bf16* UPO = (const bf16*)LDWS(WS_UPO); bf16* MIX = (bf16*)LDWS(WS_MIX); const float* mix_gain = LDF(12) + l * D;
            _Pragma("unroll 1") for (int rep = 0; rep < DUP_MLA; ++rep)
            for (int u = gwp; u < 32 * 64; u += ngw) {
                const int bh = u >> 6, i64 = u & 63, c8 = i64 >> 3, w = i64 & 7, blk = (w < 4) ? c8 * 4 + w : 63 - (c8 * 4 + (w - 4));
                const int b = bh >> 2, h = bh & 3; const bf16* Ub = UPO + (size_t)b * SEQ * UPN;
                FaSrc S{Ub + h * 96, UPN, Ub + 384 + h * 128, UPN, PROJ + (size_t)b * SEQ * INP + O_BKR, INP, Ub + 384 + h * 128 + 64, UPN};
                fa_unit<6, 4, 0>(S, blk * 32, vt, MIX + (size_t)b * SEQ * D + 384 + h * 64, mix_gain + 384 + h * 64, nullptr, lane);
            }
            { const float* GT = (const float*)LDWS(WS_GT);
              _Pragma("unroll 1") for (int rep = 0; rep < DUP_RET; ++rep)
              for (int u0 = ((gwp & 7) < 4 ? 3 * ((gwp >> 3) * 4 + (gwp & 7)) : 48 * 64); u0 < 48 * 64; u0 += 3 * (ngw >> 1))
              for (int u = u0; u < u0 + 3; ++u) { const int bh = u >> 6, n = (u >> 2) & 15, j = u & 3, b = bh / 6, h = bh % 6; const bf16* Pb = PROJ + (size_t)b * SEQ * INP;
                  FaSrc S{Pb + O_CQ + h * 32, INP, Pb + O_CK + h * 32, INP, nullptr, 0, Pb + O_CV + h * 64, INP};
                  ret_pass2(S, n, j, GT + (size_t)bh * 16 * 2048, vt, MIX + (size_t)b * SEQ * D + 640 + h * 64, mix_gain + 640 + h * 64, Pb + O_CG + h * 64, lane); } }
        }
        SEAM(sb + 2);
        if (PHM(6) && IN(sb + 3)) {
            float* out = LDOUT(); const float* x_in = LDF(0);
            pg8::Gemm g{(const bf16*)LDWS(WS_MIX), (const bf16*)LDWS(WS_WOUT) + (size_t)l * D * D}; pg8::StaticOrder<D> S; S.init(G, FRESH_S(bx));
            pg8::EpiRes E{l == 0 ? x_in : (const float*)out, out, (const float*)LDWS(WS_MOD) + (size_t)l * BATCH * MODW + 2 * D};
            pg8::gemm_phase<pg8::EpiRes, pg8::StaticOrder<D>, true, D, D>(lds, g, S, E, wave);
        }
        SEAM(sb + 3);
        if (PHM(7) && IN(sb + 4)) _Pragma("unroll 1") for (int rep = 0; rep < DUP_LN2; ++rep) ln_rows(FRESH_S(gw), ngw, FRESH_LANE(), LDOUT(), LDF(14) + l * D, (const float*)LDWS(WS_MOD) + (size_t)l * BATCH * MODW, 3, 4, (bf16*)LDWS(WS_XN), nullptr);
        SEAM(sb + 4);
        if (PHM(8) && IN(sb + 5)) {
            pg8::Gemm g{(const bf16*)LDWS(WS_XN), (const bf16*)LDWS(WS_WGU) + (size_t)l * GU * D}; pg8::StaticOrder<GU> S; S.init(G, FRESH_S(bx));
            pg8::EpiSwiGLU E{(bf16*)LDWS(WS_PROJ)};
            _Pragma("unroll 1") for (int rep = 0; rep < DUP_GU; ++rep)
            pg8::gemm_phase<pg8::EpiSwiGLU, pg8::StaticOrder<GU>, true, D, D>(lds, g, S, E, wave);
        }
        SEAM(sb + 5);
        if (PHM(9) && IN(sb + 6)) {
            float* out = LDOUT();
            pg8::Gemm g{(const bf16*)LDWS(WS_PROJ), (const bf16*)LDWS(WS_WDN) + (size_t)l * D * FFH}; pg8::StaticOrder<D> S; S.init(G, FRESH_S(bx));
            pg8::EpiRes E{out, out, (const float*)LDWS(WS_MOD) + (size_t)l * BATCH * MODW + 5 * D};
            pg8::gemm_phase<pg8::EpiRes, pg8::StaticOrder<D>, true, FFH, FFH>(lds, g, S, E, wave);
        }
        SEAM(sb + 6);
        if (PHM(10) && IN(sb + 7)) {
            const int lane = FRESH_LANE(), gwp = FRESH_S(gw);
            float* out = LDOUT();
            if (l + 1 < DEPTH) ln_rows(gwp, ngw, lane, out, LDF(6) + (l + 1) * D, (const float*)LDWS(WS_MOD) + (size_t)(l + 1) * BATCH * MODW, 0, 1, (bf16*)LDWS(WS_XN), nullptr);
            else ln_rows(gwp, ngw, lane, out, LDF(18), nullptr, 0, 0, nullptr, out);
        }
        if (sb + 8 < NSTEPS) SEAM(sb + 7);
    }
#undef IN
#undef SEAM
}

extern "C" void kernel_launch(void* const* d_in, const int* in_sizes, int n_in, void* d_out, int out_size, void* d_ws, size_t ws_size, hipStream_t stream) {
    static int grid = 0;
    if (grid == 0) {
        if (n_in != 19 || out_size != M * D || ws_size < WS_END) { fprintf(stderr, "kernel_launch: unexpected shapes (n_in %d out %d ws %zu need %zu)\n", n_in, out_size, ws_size, (size_t)WS_END); grid = -1; return; }
        int dev = 0, cus = 0, per_cu = 0;
        if (hipGetDevice(&dev) != hipSuccess || hipDeviceGetAttribute(&cus, hipDeviceAttributeMultiprocessorCount, dev) != hipSuccess) { grid = -1; return; }
        if (hipFuncSetAttribute((const void*)fwd, hipFuncAttributeMaxDynamicSharedMemorySize, LDS_BYTES) != hipSuccess) { fprintf(stderr, "kernel_launch: hipFuncSetAttribute failed\n"); grid = -1; return; }
        if (hipOccupancyMaxActiveBlocksPerMultiprocessor(&per_cu, (const void*)fwd, NWAVES * 64, LDS_BYTES) != hipSuccess || per_cu < 1) fprintf(stderr, "kernel_launch: occupancy query reports %d\n", per_cu);
        (void)hipGetLastError();
        grid = cus;
    }
    if (grid < 0) return;
    if (hipMemsetAsync((char*)d_ws + WS_CTL, 0, CTL_ZERO_BYTES, stream) != hipSuccess) return;
    Args a{};
    for (int i = 0; i < 19; ++i) a.in[i] = (const float*)d_in[i];
    a.out = (float*)d_out; a.ws = (unsigned char*)d_ws;
    if (MK_N_LAUNCHES == 1) { a.st_lo = 0; a.st_hi = NSTEPS; hipLaunchKernelGGL(fwd, dim3(grid), dim3(NWAVES * 64), LDS_BYTES, stream, a); }
    else for (int s = 0; s < NSTEPS; ++s) { a.st_lo = s; a.st_hi = s + 1; hipLaunchKernelGGL(fwd, dim3(grid), dim3(NWAVES * 64), LDS_BYTES, stream, a); }
    const hipError_t le = hipPeekAtLastError();
    if (le != hipSuccess) fprintf(stderr, "kernel_launch: launch failed: %s\n", hipGetErrorName(le));
}
```

```cpp
#include <hip/hip_runtime.h>
#include <cstdio>
#include <cstdint>
#include <cmath>

#define LAS __attribute__((address_space(3)))
#define GAS __attribute__((address_space(1)))
#ifndef MK_N_LAUNCHES
#define MK_N_LAUNCHES 1
#endif

typedef unsigned short bf16;
#define FRESH_LANE() ({ int l_; asm volatile("v_mbcnt_lo_u32_b32 %0, -1, 0\n\tv_mbcnt_hi_u32_b32 %0, -1, %0" : "=v"(l_)); l_; })
typedef short bf16x8 __attribute__((ext_vector_type(8)));
typedef short s16x4 __attribute__((ext_vector_type(4)));
typedef float f32x2 __attribute__((ext_vector_type(2)));
typedef float f32x4 __attribute__((ext_vector_type(4)));
typedef float f32x16 __attribute__((ext_vector_type(16)));
typedef unsigned u32x2 __attribute__((ext_vector_type(2)));
typedef unsigned u32x4 __attribute__((ext_vector_type(4)));

constexpr int D = 1024, BATCH = 8, SEQ = 2048, DEPTH = 4, M = BATCH * SEQ;
constexpr int INW = 2720, INP = 2816, FFH = 2816, GU = 2 * FFH, UPK = 384, UPN = 1024, MODW = 6 * D;
constexpr int O_AQ = 0, O_AK = 384, O_AV = 768, O_BQ = 1152, O_BKR = 1536, O_CQ = 1568, O_CK = 1760, O_CV = 1952, O_CG = 2336;
constexpr float EPS = 1e-6f, LOG2E = 1.4426950408889634f;
constexpr float NEG_INF = -__builtin_huge_valf();

__device__ const unsigned char BUCKET[3][129] = {
 {0, 1, 2, 3, 4, 5, 6, 7, 8, 9, 10, 11, 12, 13, 14, 15, 16, 16, 16, 16, 16, 16, 17, 17, 17, 17, 17, 17, 17, 17, 18, 18, 18, 18, 18, 18, 18, 18, 18, 18, 19, 19, 19, 19, 19, 19, 19, 19, 19, 19, 19, 19, 19, 19, 20, 20, 20, 20, 20, 20, 20, 20, 20, 20, 20, 20, 20, 20, 20, 20, 20, 20, 20, 21, 21, 21, 21, 21, 21, 21, 21, 21, 21, 21, 21, 21, 21, 21, 21, 21, 21, 21, 21, 21, 21, 21, 21, 21, 21, 22, 22, 22, 22, 22, 22, 22, 22, 22, 22, 22, 22, 22, 22, 22, 22, 22, 22, 22, 22, 22, 22, 22, 22, 22, 22, 22, 22, 22, 22},
 {0, 4, 8, 12, 16, 16, 17, 17, 18, 18, 19, 19, 19, 19, 20, 20, 20, 20, 20, 21, 21, 21, 21, 21, 21, 22, 22, 22, 22, 22, 22, 22, 22, 22, 23, 23, 23, 23, 23, 23, 23, 23, 23, 23, 23, 23, 24, 24, 24, 24, 24, 24, 24, 24, 24, 24, 24, 24, 24, 24, 24, 24, 25, 25, 25, 25, 25, 25, 25, 25, 25, 25, 25, 25, 25, 25, 25, 25, 25, 25, 25, 25, 25, 26, 26, 26, 26, 26, 26, 26, 26, 26, 26, 26, 26, 26, 26, 26, 26, 26, 26, 26, 26, 26, 26, 26, 26, 26, 26, 26, 26, 26, 26, 27, 27, 27, 27, 27, 27, 27, 27, 27, 27, 27, 27, 27, 27, 27, 27},
 {0, 16, 18, 19, 20, 21, 21, 22, 22, 23, 23, 23, 24, 24, 24, 24, 25, 25, 25, 25, 25, 26, 26, 26, 26, 26, 26, 26, 26, 27, 27, 27, 27, 27, 27, 27, 27, 27, 27, 28, 28, 28, 28, 28, 28, 28, 28, 28, 28, 28, 28, 28, 29, 29, 29, 29, 29, 29, 29, 29, 29, 29, 29, 29, 29, 29, 29, 29, 29, 29, 30, 30, 30, 30, 30, 30, 30, 30, 30, 30, 30, 30, 30, 30, 30, 30, 30, 30, 30, 30, 30, 30, 30, 30, 30, 31, 31, 31, 31, 31, 31, 31, 31, 31, 31, 31, 31, 31, 31, 31, 31, 31, 31, 31, 31, 31, 31, 31, 31, 31, 31, 31, 31, 31, 31, 31, 31, 31, 31}};
__device__ const float INV_FREQ[16] = {0x1.0000000000000p+0f, 0x1.1feb340000000p-1f, 0x1.43d1360000000p-2f, 0x1.6c310e0000000p-3f, 0x1.99999a0000000p-4f, 0x1.ccab840000000p-5f, 0x1.030dc60000000p-5f, 0x1.235a720000000p-6f, 0x1.47ae140000000p-7f, 0x1.7089380000000p-8f, 0x1.9e7c700000000p-9f, 0x1.d22a500000000p-10f, 0x1.0624de0000000p-10f, 0x1.26d42c0000000p-11f, 0x1.4b96c00000000p-12f, 0x1.74eea60000000p-13f};
__device__ const float LOG_G[6] = {-0x1.0415d80000000p-5f, -0x1.0205660000000p-6f, -0x1.0101580000000p-7f, -0x1.0080560000000p-8f, -0x1.0040160000000p-9f, -0x1.0020060000000p-10f};

__device__ __forceinline__ unsigned cvtpk(float lo, float hi) { typedef __bf16 b2 __attribute__((ext_vector_type(2))); f32x2 v = {lo, hi}; b2 b = __builtin_convertvector(v, b2); return __builtin_bit_cast(unsigned, b); }
__device__ __forceinline__ float bf2f(unsigned short b) { return __uint_as_float((unsigned)b << 16); }
__device__ __forceinline__ float ex2(float x) { return __builtin_amdgcn_exp2f(x); }
__device__ __forceinline__ float silu_fast(float v) { return v * __builtin_amdgcn_rcpf(1.f + ex2(-v * LOG2E)); }
__device__ __forceinline__ float wave_sum(float v) {
#pragma unroll
    for (int o = 1; o < 64; o <<= 1) v += __shfl_xor(v, o);
    return v;
}
__device__ __forceinline__ float xmax32(float v) { auto r = __builtin_amdgcn_permlane32_swap(__float_as_uint(v), __float_as_uint(v), false, false); return fmaxf(__uint_as_float(r[0]), __uint_as_float(r[1])); }
__device__ __forceinline__ float xsum32(float v) { auto r = __builtin_amdgcn_permlane32_swap(__float_as_uint(v), __float_as_uint(v), false, false); return __uint_as_float(r[0]) + __uint_as_float(r[1]); }
__device__ __forceinline__ float xmax16(float v) { auto r = __builtin_amdgcn_permlane16_swap(__float_as_uint(v), __float_as_uint(v), false, false); return fmaxf(__uint_as_float(r[0]), __uint_as_float(r[1])); }
__device__ __forceinline__ float xsum16(float v) { auto r = __builtin_amdgcn_permlane16_swap(__float_as_uint(v), __float_as_uint(v), false, false); return __uint_as_float(r[0]) + __uint_as_float(r[1]); }
__device__ __forceinline__ int crow(int r, int hi) { return (r & 3) + 8 * (r >> 2) + 4 * hi; }
typedef short v4i16_t __attribute__((ext_vector_type(4)));
__device__ __forceinline__ s16x4 trrd(const LAS char* p) { return __builtin_bit_cast(s16x4, __builtin_amdgcn_ds_read_tr16_b64_v4i16((LAS v4i16_t*)p)); }

namespace pg8 {
typedef unsigned short bf16_t;
constexpr int BM = 256, BK = 64, HALF = 128, HTB = HALF * BK * 2, STAGE_BYTES = 8 * HTB, NXCD = 8, WGM = 8;
__host__ __device__ __forceinline__ int lds_byte(int r, int c) { const int st = (r >> 4) * 2 + (c >> 5), rr = r & 15, cc = c & 31, ob = rr * 64 + cc * 2; return st * 1024 + (ob ^ (((ob >> 9) & 1) << 5)); }
__host__ __device__ __forceinline__ void stage_rc(int b, int& R, int& C) { const int st = b / 1024, sb = b % 1024, swz = sb ^ (((sb >> 9) & 1) << 5); R = (st >> 1) * 16 + swz / 64; C = (st & 1) * 32 + (swz % 64) / 2; }
__host__ __device__ __forceinline__ int perm32(int rho) { const int n = rho >> 4, i = rho & 15; return 8 * (i >> 2) + 4 * n + (i & 3); }
struct Unit { int pm, pn; };
struct Gemm { const bf16_t* A; const bf16_t* Bt; };
template <int N_>
struct StaticOrder {
    static constexpr int nM = 64, nN = N_ / BM, nwg = nM * nN;
    int G, c;
    __host__ __device__ void init(int G_, int c_) { G = G_; c = c_; }
    __host__ __device__ bool next(int i, Unit& u) const {
        const long L = (long)i * G + c; if (L >= nwg) return false;
        int wgid = (int)L; { const int q = nwg / NXCD, r = nwg % NXCD, xcd = wgid % NXCD, off = wgid / NXCD; wgid = (xcd < r ? xcd * (q + 1) : r * (q + 1) + (xcd - r) * q) + off; }
        const int nig = WGM * nN, gid = wgid / nig, fm = gid * WGM, gsz = (nM - fm) < WGM ? (nM - fm) : WGM;
        u.pm = fm + ((wgid % nig) % gsz); u.pn = (wgid % nig) / gsz; return true;
    }
};

template <class Epi, class Sched, bool ALIGN_EPI, int K, int lda>
__device__ __forceinline__ void gemm_phase(LAS unsigned char* lds, const Gemm g, const Sched& S, const Epi& E, const int wid_in) {
    int wid = wid_in; asm volatile("" : "+s"(wid));
    const int lane = FRESH_LANE(), tid = wid * 64 + lane;
    const int wr = wid >> 2, wc = wid & 3, fr = lane & 15, fq = lane >> 4;
    constexpr int nt = K / BK;
    unsigned voffA[2], voffB[2];
#pragma unroll
    for (int i = 0; i < 2; ++i) { int R, C; stage_rc(tid * 16 + i * 8192, R, C); const int Rb = Epi::PERM ? ((R & ~31) + perm32(R & 31)) : R;
        voffA[i] = (unsigned)(R * lda + C) * 2u; voffB[i] = (unsigned)(Rb * K + C) * 2u; }
    constexpr size_t kstep = (size_t)(BK * 2);
    constexpr size_t hstepA = (size_t)HALF * lda * 2, hstepB = (size_t)HALF * K * 2;
    constexpr size_t tstepA = 2 * hstepA, tstepB = 2 * hstepB;
    const unsigned ldsw = (unsigned)wid * 1024u;
    const int aoff = lds_byte(wr * 64 + fr, fq * 8), boff = lds_byte(wc * 32 + fr, fq * 8);
#define PG8_SA(b, h) (((b) * 2 + (h)) * HTB)
#define PG8_SB(b, h) ((4 + (b) * 2 + (h)) * HTB)
#define PG8_STAGE(bufoff, gbase, voff) do { _Pragma("unroll") for (int _i = 0; _i < 2; ++_i) \
        __builtin_amdgcn_global_load_lds((const unsigned*)((const char*)(gbase) + (voff)[_i]), (LAS unsigned*)(lds + (bufoff) + ldsw + _i * 8192), 16, 0, 0); } while (0)
#define PG8_LDA(dst, b, h) do { _Pragma("unroll") for (int m = 0; m < 4; ++m) _Pragma("unroll") for (int k = 0; k < 2; ++k) dst[m][k] = *(const LAS bf16x8*)(lds + PG8_SA(b, h) + aoff + m * 2048 + k * 1024); } while (0)
#define PG8_LDB(dst, b, h) do { _Pragma("unroll") for (int n = 0; n < 2; ++n) _Pragma("unroll") for (int k = 0; k < 2; ++k) dst[n][k] = *(const LAS bf16x8*)(lds + PG8_SB(b, h) + boff + n * 2048 + k * 1024); } while (0)
#define PG8_MMA(ai, bj, At, Bt) do { __builtin_amdgcn_s_setprio(1); _Pragma("unroll") for (int m = 0; m < 4; ++m) _Pragma("unroll") for (int n = 0; n < 2; ++n) _Pragma("unroll") for (int k = 0; k < 2; ++k) \
        acc[ai][bj][m][n] = __builtin_amdgcn_mfma_f32_16x16x32_bf16(Bt[n][k], At[m][k], acc[ai][bj][m][n], 0, 0, 0); __builtin_amdgcn_s_setprio(0); } while (0)
#define PG8_WAIT_V(n) asm volatile("s_waitcnt vmcnt(" #n ")" ::: "memory")
#define PG8_WAIT_L(n) asm volatile("s_waitcnt lgkmcnt(" #n ")" ::: "memory")
#define PG8_BAR __builtin_amdgcn_s_barrier()
#define PG8_SCHED __builtin_amdgcn_sched_barrier(0)
    Unit cur, nxt; int ui = 0;
    if (!S.next(0, cur)) return;
    f32x4 acc[2][2][4][2];
#pragma unroll
    for (int a = 0; a < 2; ++a)
#pragma unroll
        for (int b = 0; b < 2; ++b)
#pragma unroll
            for (int m = 0; m < 4; ++m)
#pragma unroll
                for (int n = 0; n < 2; ++n) acc[a][b][m][n] = (f32x4){0.f, 0.f, 0.f, 0.f};
    bf16x8 At[4][2], B0[2][2], B1[2][2];
    const char* cA = (const char*)g.A + (size_t)cur.pm * tstepA; const char* cB = (const char*)g.Bt + (size_t)cur.pn * tstepB;
    PG8_STAGE(PG8_SB(0, 0), cB, voffB); PG8_STAGE(PG8_SB(0, 1), cB + hstepB, voffB); PG8_STAGE(PG8_SA(0, 0), cA, voffA); PG8_STAGE(PG8_SA(0, 1), cA + hstepA, voffA);
    if (wr == 1) PG8_BAR;
    PG8_WAIT_V(2); PG8_BAR;
    PG8_STAGE(PG8_SB(1, 0), cB + kstep, voffB); PG8_STAGE(PG8_SA(1, 0), cA + kstep, voffA); PG8_STAGE(PG8_SB(1, 1), cB + hstepB + kstep, voffB);
    PG8_WAIT_V(6); PG8_BAR;
    for (;;) {
        const bool has_next = S.next(ui + 1, nxt);
        const char* nA = has_next ? (const char*)g.A + (size_t)nxt.pm * tstepA : cA; const char* nB = has_next ? (const char*)g.Bt + (size_t)nxt.pn * tstepB : cB;
        for (int t = 0; t < nt; t += 2) {
            const bool last = (t == nt - 2);
            const char* a1 = cA + (size_t)(t + 1) * kstep;
            const char* a2 = last ? nA : cA + (size_t)(t + 2) * kstep; const char* b2 = last ? nB : cB + (size_t)(t + 2) * kstep;
            const char* a3 = a2 + kstep; const char* b3 = b2 + kstep;
            PG8_LDB(B0, 0, 0); PG8_LDB(B1, 0, 1); PG8_SCHED; PG8_LDA(At, 0, 0); PG8_STAGE(PG8_SA(1, 1), a1 + hstepA, voffA);
            PG8_WAIT_V(8); PG8_WAIT_L(0); PG8_BAR; PG8_MMA(0, 0, At, B0); PG8_MMA(0, 1, At, B1); PG8_BAR; PG8_SCHED;
            PG8_LDA(At, 0, 1); PG8_STAGE(PG8_SB(0, 0), b2, voffB); PG8_STAGE(PG8_SB(0, 1), b2 + hstepB, voffB); PG8_STAGE(PG8_SA(0, 0), a2, voffA);
            PG8_WAIT_V(8); PG8_WAIT_L(0); PG8_BAR; PG8_MMA(1, 0, At, B0); PG8_MMA(1, 1, At, B1); PG8_BAR; PG8_SCHED;
            PG8_LDB(B0, 1, 0); PG8_LDB(B1, 1, 1); PG8_SCHED; PG8_LDA(At, 1, 0); PG8_STAGE(PG8_SA(0, 1), a2 + hstepA, voffA);
            PG8_WAIT_V(8); PG8_WAIT_L(0); PG8_BAR; PG8_MMA(0, 0, At, B0); PG8_MMA(0, 1, At, B1); PG8_BAR; PG8_SCHED;
            PG8_LDA(At, 1, 1); PG8_STAGE(PG8_SB(1, 0), b3, voffB); PG8_STAGE(PG8_SB(1, 1), b3 + hstepB, voffB); PG8_STAGE(PG8_SA(1, 0), a3, voffA);
            PG8_WAIT_V(8); PG8_WAIT_L(0); PG8_BAR; PG8_MMA(1, 0, At, B0); PG8_MMA(1, 1, At, B1); PG8_BAR; PG8_SCHED;
        }
        if constexpr (ALIGN_EPI) { if (wr == 0) PG8_BAR; }
        E(acc, cur, wr, wc, fr, fq);
        if (!has_next) break;
#pragma unroll
        for (int a = 0; a < 2; ++a)
#pragma unroll
            for (int b = 0; b < 2; ++b)
#pragma unroll
                for (int m = 0; m < 4; ++m)
#pragma unroll
                    for (int n = 0; n < 2; ++n) acc[a][b][m][n] = (f32x4){0.f, 0.f, 0.f, 0.f};
        cur = nxt; cA = nA; cB = nB; ++ui;
        if constexpr (ALIGN_EPI) { if (wr == 1) PG8_BAR; }
    }
    PG8_WAIT_V(0);
    if constexpr (!ALIGN_EPI) { if (wr == 0) PG8_BAR; }
    PG8_BAR;
#undef PG8_SA
#undef PG8_SB
#undef PG8_STAGE
#undef PG8_LDA
#undef PG8_LDB
#undef PG8_MMA
#undef PG8_WAIT_V
#undef PG8_WAIT_L
#undef PG8_BAR
#undef PG8_SCHED
}

__device__ __forceinline__ void rope8(f32x4& v0, f32x4& v1, const float* ropec, const float* ropes, int row, int fq) {
    f32x4 p0, p1;
#pragma unroll
    for (int j = 0; j < 4; ++j) { p0[j] = __shfl_xor(v0[j], 32); p1[j] = __shfl_xor(v1[j], 32); }
    const float* cr = ropec + (size_t)row * 16 + 8 * (fq & 1); const float* sr = ropes + (size_t)row * 16 + 8 * (fq & 1);
    const f32x4 c0 = *(const f32x4*)cr, c1 = *(const f32x4*)(cr + 4), s0 = *(const f32x4*)sr, s1 = *(const f32x4*)(sr + 4);
    const float sg = (fq >> 1) ? 1.f : -1.f;
    v0 = v0 * c0 + p0 * s0 * sg; v1 = v1 * c1 + p1 * s1 * sg;
}
__device__ __forceinline__ void store8(bf16_t* p, f32x4 v0, f32x4 v1) { u32x4 w; w.x = cvtpk(v0[0], v0[1]); w.y = cvtpk(v0[2], v0[3]); w.z = cvtpk(v1[0], v1[1]); w.w = cvtpk(v1[2], v1[3]); *(u32x4*)p = w; }

struct EpiInProj {
    static constexpr bool PERM = true;
    bf16_t* O; float* ssp; const float* ropec; const float* ropes;
    __device__ __forceinline__ void operator()(const f32x4 (&acc)[2][2][4][2], const Unit& u, int wr, int wc, int fr, int fq) const {
        { const int ln_ = FRESH_LANE(); fr = ln_ & 15; fq = ln_ >> 4; }
#pragma unroll
        for (int bj = 0; bj < 2; ++bj) {
            const int g = u.pn * 8 + bj * 4 + wc;
            if (g >= 85) continue;
            const int col0 = g * 32 + 8 * fq;
#pragma unroll
            for (int ai = 0; ai < 2; ++ai)
#pragma unroll
                for (int m = 0; m < 4; ++m) {
                    const int row = u.pm * BM + ai * HALF + wr * 64 + m * 16 + fr;
                    f32x4 v0 = acc[ai][bj][m][0], v1 = acc[ai][bj][m][1];
                    if (g < 12) { v0 = v0 * (0.125f * LOG2E); v1 = v1 * (0.125f * LOG2E); }
                    else if (g >= 36 && g < 48) {
                        float ss = (v0[0] * v0[0] + v0[1] * v0[1]) + (v0[2] * v0[2] + v0[3] * v0[3]) + (v1[0] * v1[0] + v1[1] * v1[1]) + (v1[2] * v1[2] + v1[3] * v1[3]);
                        ss += __shfl_xor(ss, 16); ss += __shfl_xor(ss, 32);
                        if (fq == 0) ssp[(size_t)row * 12 + (g - 36)] = ss;
                    } else if (g >= 48 && g < 61) {
                        rope8(v0, v1, ropec, ropes, row, fq);
                        if (g >= 49) {
                            const int t = row & (SEQ - 1); const bool isk = g >= 55; const int hh = isk ? g - 55 : g - 49;
                            const float e = (float)(isk ? 1024 - t : t - 1024) * (LOG_G[hh] * LOG2E);
                            const float sc = ex2(e) * (isk ? 0.17677669529663687f : 1.f);
                            v0 = v0 * sc; v1 = v1 * sc;
                        }
                    }
                    store8(O + (size_t)row * INP + col0, v0, v1);
                    asm volatile("" ::: "memory");
                }
        }
    }
};
struct EpiUp {
    static constexpr bool PERM = true;
    bf16_t* O; const float* ssp; const float* ropec; const float* ropes;
    __device__ __forceinline__ void operator()(const f32x4 (&acc)[2][2][4][2], const Unit& u, int wr, int wc, int fr, int fq) const {
        { const int ln_ = FRESH_LANE(); fr = ln_ & 15; fq = ln_ >> 4; }
#pragma unroll
        for (int ai = 0; ai < 2; ++ai)
#pragma unroll
            for (int m = 0; m < 4; ++m) {
                asm volatile("" ::: "memory");
                const int row = u.pm * BM + ai * HALF + wr * 64 + m * 16 + fr;
                const f32x4 a0 = *(const f32x4*)(ssp + (size_t)row * 12), a1 = *(const f32x4*)(ssp + (size_t)row * 12 + 4), a2 = *(const f32x4*)(ssp + (size_t)row * 12 + 8);
                const float sq = ((a0[0] + a0[1]) + (a0[2] + a0[3])) + ((a1[0] + a1[1]) + (a1[2] + a1[3])), skv = (a2[0] + a2[1]) + (a2[2] + a2[3]);
                const float rq = rsqrtf(sq * (1.f / 256.f) + EPS) * (0.10206207261596575f * LOG2E), rkv = rsqrtf(skv * (1.f / 128.f) + EPS);
#pragma unroll
                for (int bj = 0; bj < 2; ++bj) {
                    const int g = u.pn * 8 + bj * 4 + wc;
                    if (g >= 28) continue;
                    f32x4 v0 = acc[ai][bj][m][0], v1 = acc[ai][bj][m][1];
                    if (g < 12) { if ((g % 3) == 2) rope8(v0, v1, ropec, ropes, row, fq); v0 = v0 * rq; v1 = v1 * rq; }
                    else { v0 = v0 * rkv; v1 = v1 * rkv; }
                    store8(O + (size_t)row * UPN + g * 32 + 8 * fq, v0, v1);
                }
            }
    }
};
struct EpiRes {
    static constexpr bool PERM = false;
    const float* res; float* out; const float* gate;
    __device__ __forceinline__ void operator()(const f32x4 (&acc)[2][2][4][2], const Unit& u, int wr, int wc, int fr, int fq) const {
        { const int ln_ = FRESH_LANE(); fr = ln_ & 15; fq = ln_ >> 4; }
        const int col0 = u.pn * BM + wc * 32 + 4 * fq; const float* gp = gate + (size_t)(u.pm >> 3) * MODW + col0;
        f32x4 gv[2][2];
#pragma unroll
        for (int bj = 0; bj < 2; ++bj)
#pragma unroll
            for (int n = 0; n < 2; ++n) gv[bj][n] = *(const f32x4*)(gp + bj * HALF + n * 16);
#pragma unroll
        for (int ai = 0; ai < 2; ++ai)
#pragma unroll
            for (int m = 0; m < 4; ++m) { const size_t off = (size_t)(u.pm * BM + ai * HALF + wr * 64 + m * 16 + fr) * D + col0;
#pragma unroll
                for (int bj = 0; bj < 2; ++bj)
#pragma unroll
                    for (int n = 0; n < 2; ++n) { const f32x4 r = *(const f32x4*)(res + off + bj * HALF + n * 16); *(f32x4*)(out + off + bj * HALF + n * 16) = r + gv[bj][n] * acc[ai][bj][m][n]; }
                if (m & 1) asm volatile("" ::: "memory"); }
    }
};
struct EpiSwiGLU {
    static constexpr bool PERM = true;
    bf16_t* O;
    __device__ __forceinline__ void operator()(const f32x4 (&acc)[2][2][4][2], const Unit& u, int wr, int wc, int fr, int fq) const {
        { const int ln_ = FRESH_LANE(); fr = ln_ & 15; fq = ln_ >> 4; }
        const int col0 = u.pn * HALF + wc * 32 + 8 * fq;
#pragma unroll
        for (int ai = 0; ai < 2; ++ai)
#pragma unroll
            for (int m = 0; m < 4; ++m) { const int row = u.pm * BM + ai * HALF + wr * 64 + m * 16 + fr;
                f32x4 v0, v1;
#pragma unroll
                for (int j = 0; j < 4; ++j) { v0[j] = silu_fast(acc[ai][0][m][0][j]) * acc[ai][1][m][0][j]; v1[j] = silu_fast(acc[ai][0][m][1][j]) * acc[ai][1][m][1][j]; }
                store8(O + (size_t)row * FFH + col0, v0, v1); }
    }
};
}

__device__ __forceinline__ int vt_chunk_off(int key, int c) { return (c >> 2) * 2048 + key * 64 + (((c & 3) ^ (((key >> 3) & 1) << 1)) << 4); }
__device__ __forceinline__ void vt_stage(LAS char* vt, const u32x4 (&vr)[4], int lane) {
#pragma unroll
    for (int e = 0; e < 4; ++e) *(LAS u32x4*)(vt + vt_chunk_off(8 * e + (lane >> 3), lane & 7)) = vr[e];
}

struct FaSrc { const bf16* q; int ldq; const bf16* k1; int ldk1; const bf16* k2; int ldk2; const bf16* v; int ldv; };
template <int NKS, int NKS1>
__device__ __forceinline__ void fa_load(bf16x8 (&kf)[NKS], u32x4 (&vr)[4], const FaSrc& S, int k0, int lane) {
    const int r = lane & 31, h = lane >> 5;
#pragma unroll
    for (int s = 0; s < NKS; ++s) {
        const bf16* p = (s < NKS1) ? S.k1 + (size_t)(k0 + r) * S.ldk1 + 16 * s + 8 * h : S.k2 + (size_t)(k0 + r) * S.ldk2 + 16 * (s - NKS1) + 8 * h;
        kf[s] = *(const bf16x8*)p; }
#pragma unroll
    for (int e = 0; e < 4; ++e) vr[e] = *(const u32x4*)(S.v + (size_t)(k0 + 8 * e + (lane >> 3)) * S.ldv + 8 * (lane & 7));
}
template <int NKS, bool SOFTMAX>
__device__ __forceinline__ void fa_tile(const bf16x8 (&kf)[NKS], const u32x4 (&vr)[4], const bf16x8 (&qf)[NKS], f32x16 (&O)[2], float& m, float& l, LAS char* vt, int k0, int q0, bool diag, int lane) {
    const int r = lane & 31, h = lane >> 5;
    vt_stage(vt, vr, lane);
    f32x16 S;
#pragma unroll
    for (int i = 0; i < 16; ++i) S[i] = 0.f;
#pragma unroll
    for (int s = 0; s < NKS; ++s) S = __builtin_amdgcn_mfma_f32_32x32x16_bf16(kf[s], qf[s], S, 0, 0, 0);
    if (diag) {
#pragma unroll
        for (int i = 0; i < 16; ++i) if (k0 + crow(i, h) > q0 + r) S[i] = SOFTMAX ? NEG_INF : 0.f;
    }
    if (SOFTMAX) {
        float mx = S[0];
#pragma unroll
        for (int i = 1; i < 16; ++i) mx = fmaxf(mx, S[i]);
        mx = xmax32(mx);
        const float mn = fmaxf(m, mx), ms = (mn == NEG_INF) ? 0.f : mn, alpha = ex2(m - ms);
        m = mn; l *= alpha;
#pragma unroll
        for (int i = 0; i < 16; ++i) { O[0][i] *= alpha; O[1][i] *= alpha; }
        float sum = 0.f;
#pragma unroll
        for (int i = 0; i < 16; ++i) { S[i] = ex2(S[i] - ms); sum += S[i]; }
        l += sum;
    }
    bf16x8 pf[2];
#pragma unroll
    for (int s2 = 0; s2 < 2; ++s2) { u32x4 w; w.x = cvtpk(S[8 * s2 + 0], S[8 * s2 + 1]); w.y = cvtpk(S[8 * s2 + 2], S[8 * s2 + 3]); w.z = cvtpk(S[8 * s2 + 4], S[8 * s2 + 5]); w.w = cvtpk(S[8 * s2 + 6], S[8 * s2 + 7]); pf[s2] = __builtin_bit_cast(bf16x8, w); }
    const int g16 = (lane >> 4) & 1, q = (lane & 15) >> 2, p = lane & 3;
    const int ch = 2 * g16 + (p >> 1);
    const LAS char* blo = vt + (4 * h + q) * 64 + (ch << 4) + (p & 1) * 8;
    const LAS char* bhi = vt + (8 + 4 * h + q) * 64 + ((ch ^ 2) << 4) + (p & 1) * 8;
#pragma unroll
    for (int vb = 0; vb < 2; ++vb)
#pragma unroll
        for (int s2 = 0; s2 < 2; ++s2) {
            const s16x4 lo = trrd(blo + vb * 2048 + s2 * 1024), hi = trrd(bhi + vb * 2048 + s2 * 1024);
            const bf16x8 vf = {lo[0], lo[1], lo[2], lo[3], hi[0], hi[1], hi[2], hi[3]};
            O[vb] = __builtin_amdgcn_mfma_f32_32x32x16_bf16(vf, pf[s2], O[vb], 0, 0, 0);
        }
}
template <int NKS, int NKS1, int MODE>
__device__ __forceinline__ void fa_unit(const FaSrc& S, int q0, LAS char* vt, bf16* mixrow0  , const float* gain, const bf16* gate  , int lane) {
    const int r = lane & 31, h = lane >> 5;
    bf16x8 qf[NKS];
#pragma unroll
    for (int s = 0; s < NKS; ++s) qf[s] = *(const bf16x8*)(S.q + (size_t)(q0 + r) * S.ldq + 16 * s + 8 * h);
    f32x16 O[2];
#pragma unroll
    for (int i = 0; i < 16; ++i) { O[0][i] = 0.f; O[1][i] = 0.f; }
    float m = NEG_INF, l = 0.f;
    const int nt = q0 / 32 + 1;
    bf16x8 kfA[NKS], kfB[NKS]; u32x4 vrA[4], vrB[4];
    fa_load<NKS, NKS1>(kfA, vrA, S, 0, lane);
    for (int kt = 0; kt < nt; kt += 2) {
        fa_load<NKS, NKS1>(kfB, vrB, S, (kt + 1 < nt ? kt + 1 : nt - 1) * 32, lane);
        fa_tile<NKS, MODE == 0>(kfA, vrA, qf, O, m, l, vt, kt * 32, q0, kt == nt - 1, lane);
        fa_load<NKS, NKS1>(kfA, vrA, S, (kt + 2 < nt ? kt + 2 : nt - 1) * 32, lane);
        if (kt + 1 < nt) fa_tile<NKS, MODE == 0>(kfB, vrB, qf, O, m, l, vt, (kt + 1) * 32, q0, kt + 1 == nt - 1, lane);
    }
    const size_t tok = (size_t)(q0 + r);
    if (MODE == 0) {
        const float lt = xsum32(l), inv = 1.f / lt;
        float ss = 0.f;
#pragma unroll
        for (int vb = 0; vb < 2; ++vb)
#pragma unroll
            for (int i = 0; i < 16; ++i) { O[vb][i] *= inv; ss += O[vb][i] * O[vb][i]; }
        ss = xsum32(ss);
        const float rs = rsqrtf(ss * (1.f / 64.f) + EPS);
#pragma unroll
        for (int vb = 0; vb < 2; ++vb)
#pragma unroll
            for (int g = 0; g < 4; ++g) { const int d0 = 32 * vb + 8 * g + 4 * h; const f32x4 gn = *(const f32x4*)(gain + d0);
                u32x2 w; w.x = cvtpk(O[vb][4 * g] * rs * gn[0], O[vb][4 * g + 1] * rs * gn[1]); w.y = cvtpk(O[vb][4 * g + 2] * rs * gn[2], O[vb][4 * g + 3] * rs * gn[3]);
                *(u32x2*)(mixrow0 + tok * D + d0) = w; }
    } else {
        float su = 0.f;
#pragma unroll
        for (int vb = 0; vb < 2; ++vb)
#pragma unroll
            for (int i = 0; i < 16; ++i) su += O[vb][i];
        su = xsum32(su);
        const float mu = su * (1.f / 64.f); float var = 0.f;
#pragma unroll
        for (int vb = 0; vb < 2; ++vb)
#pragma unroll
            for (int i = 0; i < 16; ++i) { O[vb][i] -= mu; var += O[vb][i] * O[vb][i]; }
        var = xsum32(var);
        const float rs = rsqrtf(var * (1.f / 64.f) + EPS);
#pragma unroll
        for (int vb = 0; vb < 2; ++vb)
#pragma unroll
            for (int g = 0; g < 4; ++g) { const int d0 = 32 * vb + 8 * g + 4 * h; const f32x4 gn = *(const f32x4*)(gain + d0);
                const u32x2 gb = *(const u32x2*)(gate + tok * INP + d0);
                const float g0 = silu_fast(__uint_as_float(gb.x << 16)), g1 = silu_fast(__uint_as_float(gb.x & 0xffff0000u)), g2 = silu_fast(__uint_as_float(gb.y << 16)), g3 = silu_fast(__uint_as_float(gb.y & 0xffff0000u));
                u32x2 w; w.x = cvtpk(O[vb][4 * g] * rs * gn[0] * g0, O[vb][4 * g + 1] * rs * gn[1] * g1); w.y = cvtpk(O[vb][4 * g + 2] * rs * gn[2] * g2, O[vb][4 * g + 3] * rs * gn[3] * g3);
                *(u32x2*)(mixrow0 + tok * D + d0) = w; }
    }
}

__device__ __forceinline__ void ret_pass1(const bf16* Pb  , int h, int n, float* GTu  , LAS char* kt, LAS char* vt, int lane) {
    const int q4 = lane >> 4, q = (lane & 15) >> 2, pp = lane & 3, sw = (q4 & 1) << 1;
    f32x4 acc[2][4];
#pragma unroll
    for (int mb = 0; mb < 2; ++mb)
#pragma unroll
        for (int nb = 0; nb < 4; ++nb) acc[mb][nb] = (f32x4){0.f, 0.f, 0.f, 0.f};
    const bf16* kp = Pb + (size_t)(128 * n) * INP + O_CK + h * 32; const bf16* vp = Pb + (size_t)(128 * n) * INP + O_CV + h * 64;
    u32x4 kr[2], vr[4];
#pragma unroll
    for (int e = 0; e < 2; ++e) kr[e] = *(const u32x4*)(kp + (size_t)(16 * e + (lane >> 2)) * INP + 8 * (lane & 3));
#pragma unroll
    for (int e = 0; e < 4; ++e) vr[e] = *(const u32x4*)(vp + (size_t)(8 * e + (lane >> 3)) * INP + 8 * (lane & 7));
#pragma unroll 1
    for (int st = 0; st < 4; ++st) {
#pragma unroll
        for (int e = 0; e < 2; ++e) *(LAS u32x4*)(kt + vt_chunk_off(16 * e + (lane >> 2), lane & 3)) = kr[e];
        vt_stage(vt, vr, lane);
        const int nx = st < 3 ? st + 1 : 3;
#pragma unroll
        for (int e = 0; e < 2; ++e) kr[e] = *(const u32x4*)(kp + (size_t)(32 * nx + 16 * e + (lane >> 2)) * INP + 8 * (lane & 3));
#pragma unroll
        for (int e = 0; e < 4; ++e) vr[e] = *(const u32x4*)(vp + (size_t)(32 * nx + 8 * e + (lane >> 3)) * INP + 8 * (lane & 7));
        const LAS char* kbase = kt + (8 * q4 + q) * 64 + (pp & 1) * 8; const LAS char* vbase = vt + (8 * q4 + q) * 64 + (pp & 1) * 8;
        bf16x8 af[2], bfr[4];
#pragma unroll
        for (int mb = 0; mb < 2; ++mb) { const LAS char* pa = kbase + (((2 * mb + (pp >> 1)) ^ sw) << 4); const s16x4 lo = trrd(pa), hi = trrd(pa + 256); af[mb] = (bf16x8){lo[0], lo[1], lo[2], lo[3], hi[0], hi[1], hi[2], hi[3]}; }
#pragma unroll
        for (int nb = 0; nb < 4; ++nb) { const LAS char* pa = vbase + (nb >> 1) * 2048 + (((2 * (nb & 1) + (pp >> 1)) ^ sw) << 4); const s16x4 lo = trrd(pa), hi = trrd(pa + 256); bfr[nb] = (bf16x8){lo[0], lo[1], lo[2], lo[3], hi[0], hi[1], hi[2], hi[3]}; }
#pragma unroll
        for (int mb = 0; mb < 2; ++mb)
#pragma unroll
            for (int nb = 0; nb < 4; ++nb) acc[mb][nb] = __builtin_amdgcn_mfma_f32_16x16x32_bf16(af[mb], bfr[nb], acc[mb][nb], 0, 0, 0);
    }
#pragma unroll
    for (int mb = 0; mb < 2; ++mb)
#pragma unroll
        for (int nb = 0; nb < 4; ++nb) *(f32x4*)(GTu + (16 * nb + (lane & 15)) * 32 + 16 * mb + 4 * q4) = acc[mb][nb];
}
__device__ __forceinline__ void ret_pass2(const FaSrc& S, int n, int j, const LAS char* fl  , LAS char* vt, bf16* mixrow0, const float* gain, const bf16* gate, int lane) {
    const int r = lane & 31, h = lane >> 5, q0 = 128 * n + 32 * j;
    bf16x8 qf[2];
#pragma unroll
    for (int s = 0; s < 2; ++s) qf[s] = *(const bf16x8*)(S.q + (size_t)(q0 + r) * S.ldq + 16 * s + 8 * h);
    f32x16 O[2];
#pragma unroll
    for (int i = 0; i < 16; ++i) { O[0][i] = 0.f; O[1][i] = 0.f; }
    float m = 0.f, l = 0.f;
    bf16x8 kfA[2], kfB[2]; u32x4 vrA[4], vrB[4];
    const int t0 = 4 * n, nt = j + 1;
    fa_load<2, 2>(kfA, vrA, S, t0 * 32, lane);
#pragma unroll
    for (int vb = 0; vb < 2; ++vb)
#pragma unroll
        for (int s = 0; s < 2; ++s) { const bf16x8 fa = *(const LAS bf16x8*)(fl + (32 * vb + r) * 80 + (2 * s + h) * 16);
            O[vb] = __builtin_amdgcn_mfma_f32_32x32x16_bf16(fa, qf[s], O[vb], 0, 0, 0); }
    for (int kt = 0; kt < nt; kt += 2) {
        fa_load<2, 2>(kfB, vrB, S, (t0 + (kt + 1 < nt ? kt + 1 : nt - 1)) * 32, lane);
        fa_tile<2, false>(kfA, vrA, qf, O, m, l, vt, (t0 + kt) * 32, q0, kt == nt - 1, lane);
        fa_load<2, 2>(kfA, vrA, S, (t0 + (kt + 2 < nt ? kt + 2 : nt - 1)) * 32, lane);
        if (kt + 1 < nt) fa_tile<2, false>(kfB, vrB, qf, O, m, l, vt, (t0 + kt + 1) * 32, q0, kt + 1 == nt - 1, lane);
    }
    const size_t tok = (size_t)(q0 + r);
    float su = 0.f;
#pragma unroll
    for (int vb = 0; vb < 2; ++vb)
#pragma unroll
        for (int i = 0; i < 16; ++i) su += O[vb][i];
    su = xsum32(su);
    const float mu = su * (1.f / 64.f); float var = 0.f;
#pragma unroll
    for (int vb = 0; vb < 2; ++vb)
#pragma unroll
        for (int i = 0; i < 16; ++i) { O[vb][i] -= mu; var += O[vb][i] * O[vb][i]; }
    var = xsum32(var);
    const float rs = rsqrtf(var * (1.f / 64.f) + EPS);
#pragma unroll
    for (int vb = 0; vb < 2; ++vb)
#pragma unroll
        for (int g = 0; g < 4; ++g) { const int d0 = 32 * vb + 8 * g + 4 * h; const f32x4 gn = *(const f32x4*)(gain + d0);
            const u32x2 gb = *(const u32x2*)(gate + tok * INP + d0);
            const float g0 = silu_fast(__uint_as_float(gb.x << 16)), g1 = silu_fast(__uint_as_float(gb.x & 0xffff0000u)), g2 = silu_fast(__uint_as_float(gb.y << 16)), g3 = silu_fast(__uint_as_float(gb.y & 0xffff0000u));
            u32x2 w; w.x = cvtpk(O[vb][4 * g] * rs * gn[0] * g0, O[vb][4 * g + 1] * rs * gn[1] * g1); w.y = cvtpk(O[vb][4 * g + 2] * rs * gn[2] * g2, O[vb][4 * g + 3] * rs * gn[3] * g3);
            *(u32x2*)(mixrow0 + tok * D + d0) = w; }
}

__device__ __forceinline__ void dil_params(int si, int n3, int n2, int s2s, int s1s, int T0, int r, int& kb, int& sh, int& p) {
    if (si < n3) { p = 2; sh = 4; kb = 512 * si + r; }
    else if (si < n3 + n2) { const int s = s2s + (si - n3); p = 1; sh = 2; kb = 4 * ((T0 >> 2) + (r >> 2) - 128 + 32 * s) + (r & 3); }
    else { const int s = s1s + (si - n3 - n2); p = 0; sh = 0; kb = T0 - 128 + 32 * s; }
}
__device__ __forceinline__ int clampi(int v, int lo, int hi) { return v < lo ? lo : (v > hi ? hi : v); }
__device__ __forceinline__ void dil_load(bf16x8 (&kf)[2][2], u32x4 (&vr)[4], const bf16* P, int h, int kb, int sh, int lane) {
    const int mrow = lane & 15, q4 = lane >> 4;
#pragma unroll
    for (int a = 0; a < 2; ++a) { const int kk = 8 * (mrow >> 2) + 4 * a + (mrow & 3); const int tk = clampi(kb + (kk << sh), 0, SEQ - 1);
        const bf16* p = P + (size_t)tk * INP + O_AK + h * 64 + 8 * q4;
        kf[a][0] = *(const bf16x8*)p; kf[a][1] = *(const bf16x8*)(p + 32); }
#pragma unroll
    for (int e = 0; e < 4; ++e) { const int kk = 8 * e + (lane >> 3); const int tk = clampi(kb + (kk << sh), 0, SEQ - 1);
        vr[e] = *(const u32x4*)(P + (size_t)tk * INP + O_AV + h * 64 + 8 * (lane & 7)); }
}
__device__ __forceinline__ void dil_step(const bf16x8 (&kf)[2][2], const u32x4 (&vr)[4], bf16x8 qf0, bf16x8 qf1, f32x4 (&O)[4], float& m, float& l, LAS char* vt, const LAS float* tabh, int kb, int sh, int p, int tq, int lane) {
    const int q4 = lane >> 4;
    vt_stage(vt, vr, lane);
    f32x4 S[2];
#pragma unroll
    for (int a = 0; a < 2; ++a) { S[a] = (f32x4){0.f, 0.f, 0.f, 0.f};
        S[a] = __builtin_amdgcn_mfma_f32_16x16x32_bf16(kf[a][0], qf0, S[a], 0, 0, 0);
        S[a] = __builtin_amdgcn_mfma_f32_16x16x32_bf16(kf[a][1], qf1, S[a], 0, 0, 0); }
    const int jq = (tq - kb) >> sh;
    float sc[8];
#pragma unroll
    for (int a = 0; a < 2; ++a)
#pragma unroll
        for (int i = 0; i < 4; ++i) { const int kk = 8 * q4 + 4 * a + i, jidx = jq - kk;
            const bool valid = ((unsigned)jidx <= 128u) && (kb + (kk << sh) >= 0);
            const float b = tabh[p * 132 + clampi(jidx, 0, 128)];
            sc[4 * a + i] = (S[a][i] + b) + (valid ? 0.f : NEG_INF); }
    float mx = sc[0];
#pragma unroll
    for (int i = 1; i < 8; ++i) mx = fmaxf(mx, sc[i]);
    mx = xmax32(xmax16(mx));
    const float mn = fmaxf(m, mx), ms = (mn == NEG_INF) ? 0.f : mn, alpha = ex2(m - ms);
    m = mn; l *= alpha;
#pragma unroll
    for (int db = 0; db < 4; ++db) O[db] = O[db] * alpha;
    float sum = 0.f;
#pragma unroll
    for (int i = 0; i < 8; ++i) { sc[i] = ex2(sc[i] - ms); sum += sc[i]; }
    l += sum;
    u32x4 w; w.x = cvtpk(sc[0], sc[1]); w.y = cvtpk(sc[2], sc[3]); w.z = cvtpk(sc[4], sc[5]); w.w = cvtpk(sc[6], sc[7]);
    const bf16x8 pf = __builtin_bit_cast(bf16x8, w);
    const int q = (lane & 15) >> 2, pp = lane & 3, sw = (q4 & 1) << 1;
    const LAS char* base = vt + (8 * q4 + q) * 64 + (pp & 1) * 8;
#pragma unroll
    for (int db = 0; db < 4; ++db) {
        const int ch = 2 * (db & 1) + (pp >> 1);
        const LAS char* pa = base + (db >> 1) * 2048 + ((ch ^ sw) << 4);
        const s16x4 lo = trrd(pa), hi = trrd(pa + 4 * 64);
        const bf16x8 vf = {lo[0], lo[1], lo[2], lo[3], hi[0], hi[1], hi[2], hi[3]};
        O[db] = __builtin_amdgcn_mfma_f32_16x16x32_bf16(vf, pf, O[db], 0, 0, 0);
    }
}
__device__ __forceinline__ void dil_unit(const bf16* P, bf16* MX, int h, int T0, int r, LAS char* vt, const LAS float* tabh, const float* gain, int lane) {
    const int n = lane & 15, q4 = lane >> 4, tq = T0 + 16 * n + r;
    const bf16* qp = P + (size_t)tq * INP + O_AQ + h * 64 + 8 * q4;
    const bf16x8 qf0 = *(const bf16x8*)qp, qf1 = *(const bf16x8*)(qp + 32);
    f32x4 O[4];
#pragma unroll
    for (int db = 0; db < 4; ++db) O[db] = (f32x4){0.f, 0.f, 0.f, 0.f};
    float m = NEG_INF, l = 0.f;
    const int n3 = (T0 >> 9) + 1, s2s = (T0 == 0) ? 3 : ((T0 == 256) ? 1 : 0), n2 = 6 - s2s, s1s = (T0 == 0) ? 4 : 0, ns = n3 + n2 + 12 - s1s;
    bf16x8 kfA[2][2], kfB[2][2]; u32x4 vrA[4], vrB[4];
    int kbA, shA, pA, kbB = 0, shB = 0, pB = 0;
    dil_params(0, n3, n2, s2s, s1s, T0, r, kbA, shA, pA); dil_load(kfA, vrA, P, h, kbA, shA, lane);
    for (int si = 0; si < ns; si += 2) {
        dil_params(si + 1 < ns ? si + 1 : ns - 1, n3, n2, s2s, s1s, T0, r, kbB, shB, pB); dil_load(kfB, vrB, P, h, kbB, shB, lane);
        dil_step(kfA, vrA, qf0, qf1, O, m, l, vt, tabh, kbA, shA, pA, tq, lane);
        dil_params(si + 2 < ns ? si + 2 : ns - 1, n3, n2, s2s, s1s, T0, r, kbA, shA, pA); dil_load(kfA, vrA, P, h, kbA, shA, lane);
        if (si + 1 < ns) dil_step(kfB, vrB, qf0, qf1, O, m, l, vt, tabh, kbB, shB, pB, tq, lane);
    }
    const float lt = xsum32(xsum16(l));
    const float inv = 1.f / lt; float ss = 0.f;
#pragma unroll
    for (int db = 0; db < 4; ++db) { O[db] = O[db] * inv; ss += (O[db][0] * O[db][0] + O[db][1] * O[db][1]) + (O[db][2] * O[db][2] + O[db][3] * O[db][3]); }
    ss = xsum32(xsum16(ss));
    const float rs = rsqrtf(ss * (1.f / 64.f) + EPS);
#pragma unroll
    for (int db = 0; db < 4; ++db) { const int d0 = 16 * db + 4 * q4; const f32x4 gn = *(const f32x4*)(gain + d0);
        u32x2 w; w.x = cvtpk(O[db][0] * rs * gn[0], O[db][1] * rs * gn[1]); w.y = cvtpk(O[db][2] * rs * gn[2], O[db][3] * rs * gn[3]);
        *(u32x2*)(MX + (size_t)tq * D + h * 64 + d0) = w; }
}

constexpr size_t MiB = 1u << 20;
constexpr size_t WS_CTL = 0, CTL_ZERO_BYTES = 1 * MiB;
constexpr size_t WS_MOD = 1 * MiB, WS_MODP = 2 * MiB, WS_ROPE = 9 * MiB, WS_SSP = 11 * MiB;
constexpr size_t WS_WIN = 12 * MiB, WS_WOUT = 34 * MiB, WS_WGU = 42 * MiB, WS_WDN = 86 * MiB, WS_WUP = 108 * MiB;
constexpr size_t WS_XN = 112 * MiB, WS_MIX = 144 * MiB, WS_UPO = 176 * MiB, WS_PROJ = 208 * MiB, WS_GT = 296 * MiB, WS_END = 304 * MiB;
constexpr int CW_BAR = 4096;
constexpr int RING_BYTES = 131072, LDSCTL_OFF = RING_BYTES, MISC_OFF = LDSCTL_OFF + 320, PTAB_OFF = LDSCTL_OFF + 512, TAB_OFF = LDSCTL_OFF + 768, LDS_BYTES = TAB_OFF + 6 * 3 * 132 * 4 + 64;
static_assert(LDS_BYTES <= 160 * 1024, "LDS");
constexpr int NWAVES = 8;
constexpr int NSTEPS = 3 + 8 * DEPTH;

#define XB_TMO      128
#define XB_XCNT(j)  (256  + 64 * (j))
#define XB_XSUB(j)  (1280 + 64 * (j))
#define XB_XGEN(j)  (2304 + 64 * (j))
#define XB_TOP      3328
#define XB_TOPGEN   3392
#define XCD_BAR_WORDS 3456
#define XB_SPIN_CAP (1u << 18)
typedef GAS unsigned gu32;
__device__ __forceinline__ unsigned xb_ld(gu32* p)              { return __hip_atomic_load(p, __ATOMIC_RELAXED, __HIP_MEMORY_SCOPE_AGENT); }
__device__ __forceinline__ unsigned xb_add(gu32* p, unsigned v) { return __hip_atomic_fetch_add(p, v, __ATOMIC_RELAXED, __HIP_MEMORY_SCOPE_AGENT); }
__device__ __forceinline__ unsigned xb_xcc_id() { return (unsigned)__builtin_amdgcn_s_getreg((3 << 11) | 20) & 0xFu; }
#define XB_SPIN(cond, bar) do { unsigned _sp = 0; while (cond) { __builtin_amdgcn_s_sleep(1); \
    if ((++_sp & 255u) == 0u) { if (xb_ld(&(bar)[XB_TMO])) break; if (_sp > XB_SPIN_CAP) { xb_add(&(bar)[XB_TMO], 1u); break; } } } } while (0)
struct XcdBarrier { unsigned x; volatile LAS unsigned* st; };
__device__ __forceinline__ XcdBarrier xcd_barrier_post(gu32* bar, volatile LAS unsigned* st, bool t0) {
    XcdBarrier b; b.x = xb_xcc_id(); b.st = st;
    if (t0) (void)xb_add(&bar[XB_XCNT(b.x)], 1u);
    return b;
}
__device__ __forceinline__ void xcd_barrier_complete(gu32* bar, unsigned x, unsigned& nloc, unsigned& nx) {
    const unsigned G = gridDim.x * gridDim.y * gridDim.z;
    unsigned sum, cnt, mine, sp = 0u;
    for (;;) {
        sum = 0u; cnt = 0u; mine = 0u;
#pragma unroll
        for (unsigned j = 0; j < 16; ++j) { const unsigned c = xb_ld(&bar[XB_XCNT(j)]); sum += c; cnt += (c > 0u) ? 1u : 0u; mine = (j == x) ? c : mine; }
        if (sum == G) break;
        __builtin_amdgcn_s_sleep(1);
        if ((++sp & 255u) == 0u) { if (xb_ld(&bar[XB_TMO])) break; if (sp > XB_SPIN_CAP) { xb_add(&bar[XB_TMO], 1u); break; } }
    }
    nloc = mine > 0u ? mine : 1u; nx = cnt > 0u ? cnt : 1u;
}
__device__ __forceinline__ void xcd_barrier(const XcdBarrier& b, gu32* bar_, int wave) {
    asm volatile("s_waitcnt vmcnt(0)" ::: "memory");
    __syncthreads();
    if (wave == 0 && FRESH_LANE() == 0) {
        unsigned long long bv_ = (unsigned long long)bar_; asm volatile("" : "+v"(bv_)); gu32* bar = (gu32*)bv_;
        __builtin_amdgcn_s_waitcnt(0);
        unsigned nloc = b.st[0], nx = b.st[1];
        if (nloc == 0u) { xcd_barrier_complete(bar, b.x, nloc, nx); b.st[0] = nloc; b.st[1] = nx; }
        const unsigned old = xb_add(&bar[XB_XSUB(b.x)], 1u);
        const unsigned gen = old / nloc;
        if (old + 1u == (gen + 1u) * nloc) {
            __builtin_amdgcn_fence(__ATOMIC_RELEASE, "agent");
            asm volatile("s_waitcnt vmcnt(0)" ::: "memory");
            const unsigned og = xb_add(&bar[XB_TOP], 1u);
            const unsigned tg = og / nx;
            if (og + 1u == (tg + 1u) * nx) xb_add(&bar[XB_TOPGEN], 1u);
            else XB_SPIN(xb_ld(&bar[XB_TOPGEN]) == tg, bar);
            __builtin_amdgcn_fence(__ATOMIC_ACQUIRE, "agent");
            xb_add(&bar[XB_XGEN(b.x)], 1u);
            asm volatile("s_waitcnt vmcnt(0)" ::: "memory");
        } else {
            XB_SPIN(xb_ld(&bar[XB_XGEN(b.x)]) == gen, bar);
            __builtin_amdgcn_fence(__ATOMIC_ACQUIRE, "agent");
            asm volatile("s_waitcnt vmcnt(0)" ::: "memory");
        }
    }
    __syncthreads();
}

__device__ __forceinline__ void transpose_item(const float* W, int K, int N, bf16* WT, int k0, int n0, int orow0, LAS float* scr, int lane) {
#pragma unroll 8
    for (int i = 0; i < 32; ++i) { const int kk = 2 * i + (lane >> 5); scr[kk * 33 + (lane & 31)] = W[(size_t)(k0 + kk) * N + n0 + (lane & 31)]; }
    asm volatile("s_waitcnt lgkmcnt(0)" ::: "memory");
    const int c = lane & 7;
#pragma unroll
    for (int j = 0; j < 4; ++j) { const int n = (lane >> 3) + 8 * j; const LAS float* s = scr + (8 * c) * 33 + n;
        u32x4 o; o.x = cvtpk(s[0 * 33], s[1 * 33]); o.y = cvtpk(s[2 * 33], s[3 * 33]); o.z = cvtpk(s[4 * 33], s[5 * 33]); o.w = cvtpk(s[6 * 33], s[7 * 33]);
        *(u32x4*)(WT + (size_t)(orow0 + n) * K + k0 + 8 * c) = o; }
    asm volatile("s_waitcnt lgkmcnt(0)" ::: "memory");
}
__device__ __forceinline__ void ln_rows(int gw, int ngw, int lane, const float* xin, const float* g, const float* modl, int ch_sh, int ch_sc, bf16* xn, float* outf) {
    for (int m = gw; m < M; m += ngw) {
        const f32x4* xr = (const f32x4*)(xin + (size_t)m * D) + lane;
        f32x4 v[4]; float s = 0.f;
#pragma unroll
        for (int j = 0; j < 4; ++j) { v[j] = xr[64 * j]; s += (v[j][0] * v[j][0] + v[j][1] * v[j][1]) + (v[j][2] * v[j][2] + v[j][3] * v[j][3]); }
        const float rs = rsqrtf(wave_sum(s) * (1.f / D) + EPS);
        const int b = m / SEQ;
#pragma unroll
        for (int j = 0; j < 4; ++j) { const int n0 = 4 * lane + 256 * j; f32x4 y = v[j] * rs * *(const f32x4*)(g + n0);
            if (modl) { const f32x4 sc = *(const f32x4*)(modl + (size_t)b * MODW + ch_sc * D + n0), sh = *(const f32x4*)(modl + (size_t)b * MODW + ch_sh * D + n0); y = y * (sc + 1.f) + sh; }
            if (xn) { u32x2 w; w.x = cvtpk(y[0], y[1]); w.y = cvtpk(y[2], y[3]); *(u32x2*)(xn + (size_t)m * D + n0) = w; }
            else *(f32x4*)(outf + (size_t)m * D + n0) = y; }
    }
}

struct Args { const float* in[19]; float* out; unsigned char* ws; int st_lo, st_hi; };
__global__ void __launch_bounds__(NWAVES * 64, 2) fwd(Args args) {
    extern __shared__ __attribute__((aligned(16))) unsigned char lds_raw[];
    LAS unsigned char* lds = (LAS unsigned char*)lds_raw;
    volatile LAS unsigned* MISC = (volatile LAS unsigned*)(lds + MISC_OFF);
    const int wave = __builtin_amdgcn_readfirstlane(threadIdx.x >> 6);
    const int G = gridDim.x; const int bx = blockIdx.x; const int vcu = (G % 8 == 0) ? (bx % 8) * (G / 8) + bx / 8 : bx;
    const int gw = vcu * NWAVES + wave, ngw = G * NWAVES, ngt = ngw * 64;
    LAS unsigned long long* ptab = (LAS unsigned long long*)(lds + PTAB_OFF);
    const int tid = wave * 64 + FRESH_LANE();
    if (tid == 0) {
#pragma unroll
        for (int i = 0; i < 19; ++i) ptab[i] = (unsigned long long)args.in[i];
        ptab[19] = (unsigned long long)args.out; ptab[20] = (unsigned long long)args.ws;
    }
#define FRESH_TID() (wave * 64 + FRESH_LANE())
#define FRESH_S(x) ({ int s_ = (x); asm volatile("" : "+s"(s_)); s_; })
#define LDP_RAW(i) ({ const unsigned long long v_ = ptab[i]; const unsigned lo_ = __builtin_amdgcn_readfirstlane((unsigned)v_), hi_ = __builtin_amdgcn_readfirstlane((unsigned)(v_ >> 32)); ((unsigned long long)hi_ << 32) | lo_; })
#define LDF(i) ((const float*)(const GAS float*)LDP_RAW(i))
#define LDWS(off) ((unsigned char*)(GAS unsigned char*)(LDP_RAW(20) + (off)))
#define LDOUT() ((float*)(GAS float*)LDP_RAW(19))
    for (int u = tid; u < (PTAB_OFF - LDSCTL_OFF) / 4; u += NWAVES * 64) ((LAS unsigned*)(lds + LDSCTL_OFF))[u] = 0u;
    LAS float* tab = (LAS float*)(lds + TAB_OFF);
    { const float* rel_bias = args.in[3];
      for (int u = tid; u < 6 * 3 * 129; u += NWAVES * 64) { const int j = u % 129, hp = u / 129, p = hp % 3, h = hp / 3; tab[hp * 132 + j] = rel_bias[BUCKET[p][j] * 6 + h] * LOG2E; } }
    __syncthreads();
    const int lo = args.st_lo, hi = args.st_hi;
    const XcdBarrier bar = xcd_barrier_post((gu32*)(args.ws + WS_CTL) + CW_BAR, MISC + 8, tid == 0);
#ifndef PHASE_MASK
#define PHASE_MASK 0xffff
#endif
#ifndef DUP_RET
#define DUP_RET 1
#endif
#ifndef DUP_DIL
#define DUP_DIL 1
#endif
#ifndef DUP_MLA
#define DUP_MLA 1
#endif
#ifndef DUP_INPROJ
#define DUP_INPROJ 1
#endif
#ifndef DUP_GU
#define DUP_GU 1
#endif
#ifndef DUP_LN2
#define DUP_LN2 1
#endif
#ifndef DUP_P1
#define DUP_P1 1
#endif
#ifndef DUP_P2
#define DUP_P2 1
#endif
#define PHM(b) ((PHASE_MASK >> (b)) & 1)
#define IN(k) (lo <= (k) && (k) < hi)
#define SEAM(k) do { if (IN(k) && IN((k) + 1)) xcd_barrier(bar, (gu32*)(args.ws + WS_CTL) + CW_BAR, wave); } while (0)

    if (PHM(0) && IN(0)) {
        const int tidp = FRESH_TID(), lane = tidp & 63, gt = gw * 64 + lane;
        const float* c_in = LDF(1); const int* pos = (const int*)LDF(2); const float* ada_w = LDF(4); const float* w_in = LDF(7);
        const float* q_norm = LDF(8); const float* kv_norm = LDF(9); const float* w_uq = LDF(10); const float* w_ukv = LDF(11);
        const float* w_out = LDF(13); const float* w_gate = LDF(15); const float* w_up = LDF(16); const float* w_down = LDF(17);
        float* modp = (float*)LDWS(WS_MODP); float* ropec = (float*)LDWS(WS_ROPE); float* ropes = ropec + (size_t)M * 16;
        bf16* Win_t = (bf16*)LDWS(WS_WIN); bf16* Wout_t = (bf16*)LDWS(WS_WOUT); bf16* Wgu_t = (bf16*)LDWS(WS_WGU); bf16* Wdn_t = (bf16*)LDWS(WS_WDN); bf16* Wup_t = (bf16*)LDWS(WS_WUP);
        LAS float* scr = (LAS float*)(lds + wave * 8704);
        LAS float* cact = (LAS float*)(lds + 73728);
        for (int i = tidp; i < BATCH * D; i += NWAVES * 64) { const int b = i / D, k = i % D; const float v = c_in[i]; cact[k * 8 + b] = v / (1.f + expf(-v)); }
        __syncthreads();
        for (int it = gw; it < DEPTH * 96 * 8; it += ngw) {
            const int kq = it & 7, cg = (it >> 3) % 96, l = it / (96 * 8), n = cg * 64 + lane;
            const float* wp = ada_w + ((size_t)l * D + kq * 128) * MODW + n;
            float a[8];
#pragma unroll
            for (int b = 0; b < 8; ++b) a[b] = 0.f;
#pragma unroll 16
            for (int k = 0; k < 128; ++k) { const float wv = wp[(size_t)k * MODW]; const f32x4 c0 = *(const LAS f32x4*)(cact + (kq * 128 + k) * 8), c1 = *(const LAS f32x4*)(cact + (kq * 128 + k) * 8 + 4);
                a[0] += c0[0] * wv; a[1] += c0[1] * wv; a[2] += c0[2] * wv; a[3] += c0[3] * wv; a[4] += c1[0] * wv; a[5] += c1[1] * wv; a[6] += c1[2] * wv; a[7] += c1[3] * wv; }
#pragma unroll
            for (int b = 0; b < 8; ++b) modp[(((size_t)kq * DEPTH + l) * BATCH + b) * MODW + n] = a[b];
        }
        constexpr int I_IN = 16 * 85, I_OUT = 16 * 32, I_G = 16 * 88, I_DN = 44 * 32, I_L = I_IN + I_OUT + 2 * I_G + I_DN;
        for (int it = gw; it < DEPTH * I_L; it += ngw) {
            const int l = it / I_L; int r = it % I_L;
            if (r < I_IN) { const int kb = r / 85, nb = r % 85; transpose_item(w_in + (size_t)l * D * INW, D, INW, Win_t + (size_t)l * INP * D, 64 * kb, 32 * nb, 32 * nb, scr, lane); continue; } r -= I_IN;
            if (r < I_OUT) { const int kb = r / 32, nb = r % 32; transpose_item(w_out + (size_t)l * D * D, D, D, Wout_t + (size_t)l * D * D, 64 * kb, 32 * nb, 32 * nb, scr, lane); continue; } r -= I_OUT;
            if (r < I_G) { const int kb = r / 88, nb = r % 88, n0 = 32 * nb; transpose_item(w_gate + (size_t)l * D * FFH, D, FFH, Wgu_t + (size_t)l * GU * D, 64 * kb, n0, 256 * (n0 >> 7) + (n0 & 127), scr, lane); continue; } r -= I_G;
            if (r < I_G) { const int kb = r / 88, nb = r % 88, n0 = 32 * nb; transpose_item(w_up + (size_t)l * D * FFH, D, FFH, Wgu_t + (size_t)l * GU * D, 64 * kb, n0, 256 * (n0 >> 7) + 128 + (n0 & 127), scr, lane); continue; } r -= I_G;
            { const int kb = r / 32, nb = r % 32; transpose_item(w_down + (size_t)l * FFH * D, FFH, D, Wdn_t + (size_t)l * D * FFH, 64 * kb, 32 * nb, 32 * nb, scr, lane); }
        }
        for (int i = gt; i < DEPTH * 96 * D / 8; i += ngt) { const int l = i / (96 * D / 8), r = i % (96 * D / 8); *(u32x4*)(Win_t + (size_t)l * INP * D + (size_t)INW * D + (size_t)r * 8) = (u32x4){0u, 0u, 0u, 0u}; }
        for (int i = gt; i < DEPTH * UPN * UPK; i += ngt) { const int l = i / (UPN * UPK), rr = i % (UPN * UPK), n = rr / UPK, k = rr % UPK; float v = 0.f;
            if (n < 384) { if (k < 256) v = q_norm[l * 256 + k] * w_uq[((size_t)l * 256 + k) * 384 + n]; }
            else if (n < 896) { if (k >= 256) v = kv_norm[l * 128 + (k - 256)] * w_ukv[((size_t)l * 128 + (k - 256)) * 512 + (n - 384)]; }
            Wup_t[i] = (bf16)(cvtpk(v, 0.f) & 0xffffu); }
        for (int i = gt; i < M * 16; i += ngt) { const int m = i >> 4, f = i & 15; const float ang = (float)pos[m] * INV_FREQ[f]; ropec[i] = cosf(ang); ropes[i] = sinf(ang); }
    }
    SEAM(0);
    if (PHM(1) && IN(1)) {
        const int gt = gw * 64 + (FRESH_TID() & 63);
        const float* ada_b = LDF(5); const float* modp = (const float*)LDWS(WS_MODP); float* mod = (float*)LDWS(WS_MOD);
        for (int i = gt; i < DEPTH * BATCH * MODW; i += ngt) { const int n = i % MODW, l = i / (BATCH * MODW); float s = 0.f;
#pragma unroll
            for (int kq = 0; kq < 8; ++kq) s += modp[(size_t)kq * DEPTH * BATCH * MODW + i];
            mod[i] = s + ada_b[l * MODW + n]; }
    }
    SEAM(1);
    if (PHM(2) && IN(2)) ln_rows(FRESH_S(gw), ngw, FRESH_LANE(), LDF(0), LDF(6), (const float*)LDWS(WS_MOD), 0, 1, (bf16*)LDWS(WS_XN), nullptr);
    SEAM(2);

#pragma unroll 1
    for (int l = 0; l < DEPTH; ++l) {
        const int sb = 3 + 8 * l;
        if (PHM(3) && IN(sb + 0)) {
            float* ropec = (float*)LDWS(WS_ROPE);
            pg8::Gemm g{(const bf16*)LDWS(WS_XN), (const bf16*)LDWS(WS_WIN) + (size_t)l * INP * D}; pg8::StaticOrder<INP> S; S.init(G, FRESH_S(bx));
            pg8::EpiInProj E{(bf16*)LDWS(WS_PROJ), (float*)LDWS(WS_SSP), ropec, ropec + (size_t)M * 16};
            _Pragma("unroll 1") for (int rep = 0; rep < DUP_INPROJ; ++rep)
            pg8::gemm_phase<pg8::EpiInProj, pg8::StaticOrder<INP>, true, D, D>(lds, g, S, E, wave);
        }
        SEAM(sb + 0);
        if (PHM(4) && IN(sb + 1)) _Pragma("unroll 1") for (int prep = 0; prep < DUP_P1; ++prep) {
            if (prep) { asm volatile("s_waitcnt vmcnt(0) lgkmcnt(0)" ::: "memory"); __syncthreads(); }
            { float* ropec = (float*)LDWS(WS_ROPE);
              pg8::Gemm g{(const bf16*)LDWS(WS_PROJ) + O_BQ, (const bf16*)LDWS(WS_WUP) + (size_t)l * UPN * UPK}; pg8::StaticOrder<UPN> S; S.init(G, FRESH_S(bx));
              pg8::EpiUp E{(bf16*)LDWS(WS_UPO), (const float*)LDWS(WS_SSP), ropec, ropec + (size_t)M * 16};
              pg8::gemm_phase<pg8::EpiUp, pg8::StaticOrder<UPN>, true, UPK, INP>(lds, g, S, E, wave); }
            const int lane = FRESH_LANE(), gwp = FRESH_S(gw);
            LAS char* vt = (LAS char*)(lds + FRESH_S(wave) * 4096);
            const bf16* PROJ = (const bf16*)LDWS(WS_PROJ); bf16* MIX = (bf16*)LDWS(WS_MIX); const float* mix_gain = LDF(12) + l * D;
            { float* GT = (float*)LDWS(WS_GT); LAS char* kt = (LAS char*)(lds + 32768 + FRESH_S(wave) * 2048);
              _Pragma("unroll 1") for (int rep = 0; rep < DUP_RET; ++rep)
              for (int u = gwp; u < 48 * 16; u += ngw) { const int bh = u >> 4, n = u & 15, b = bh / 6, h = bh % 6;
                  ret_pass1(PROJ + (size_t)b * SEQ * INP, h, n, GT + (size_t)u * 2048, kt, vt, lane); } }
            _Pragma("unroll 1") for (int rep = 0; rep < DUP_DIL; ++rep)
            for (int u = gwp; u < 6144; u += ngw) {
                const int r = u & 15, qb = (u >> 4) & 7, bh = u >> 7, b = bh / 6, h = bh % 6;
                dil_unit(PROJ + (size_t)b * SEQ * INP, MIX + (size_t)b * SEQ * D, h, qb * 256, r, vt, tab + h * 3 * 132, mix_gain + h * 64, lane);
            }
        }
        SEAM(sb + 1);
        if (PHM(5) && IN(sb + 2)) _Pragma("unroll 1") for (int prep = 0; prep < DUP_P2; ++prep) {
            if (prep) { asm volatile("s_waitcnt vmcnt(0) lgkmcnt(0)" ::: "memory"); __syncthreads(); }
            const int lane = FRESH_LANE(), gwp = FRESH_S(gw);
            LAS char* vt = (LAS char*)(lds + FRESH_S(wave) * 4096);
            const bf16* PROJ = (const bf16*)LDWS(WS_PROJ); const bf16* UPO = (const bf16*)LDWS(WS_UPO); bf16* MIX = (bf16*)LDWS(WS_MIX); const float* mix_gain = LDF(12) + l * D;
            { const float* GT = (const float*)LDWS(WS_GT); const int vc = gwp >> 3, t = FRESH_S(wave) * 64 + lane;
              f32x4 run = (f32x4){0.f, 0.f, 0.f, 0.f}; int pbh = -1, pn = 0;
              for (int i = 0; i < 3; ++i) { const int g = 3 * vc + i; if (g >= 768) break; const int bh = g >> 4, n = g & 15;
                  if (bh != pbh) { run = (f32x4){0.f, 0.f, 0.f, 0.f}; pn = 0; pbh = bh; }
                  const float* gp = GT + (size_t)bh * 16 * 2048 + 4 * t;
                  f32x4 a0 = run, a1 = (f32x4){0.f, 0.f, 0.f, 0.f}, a2 = a1, a3 = a1;
                  int mc = pn;
                  for (; mc + 4 <= n; mc += 4) { a0 += *(const f32x4*)(gp + (size_t)mc * 2048); a1 += *(const f32x4*)(gp + (size_t)(mc + 1) * 2048); a2 += *(const f32x4*)(gp + (size_t)(mc + 2) * 2048); a3 += *(const f32x4*)(gp + (size_t)(mc + 3) * 2048); }
                  for (; mc < n; ++mc) a0 += *(const f32x4*)(gp + (size_t)mc * 2048);
                  run = (a0 + a1) + (a2 + a3); pn = n;
                  u32x2 w; w.x = cvtpk(run[0], run[1]); w.y = cvtpk(run[2], run[3]);
                  *(LAS u32x2*)(lds + 65536 + i * 5120 + (t >> 3) * 80 + (t & 7) * 8) = w; }
              asm volatile("s_waitcnt lgkmcnt(0)" ::: "memory"); __syncthreads(); }
            _Pragma("unroll 1") for (int rep = 0; rep < DUP_MLA; ++rep)
            for (int u = gwp; u < 32 * 64; u += ngw) {
                const int bh = u >> 6, i64 = u & 63, c8 = i64 >> 3, w = i64 & 7, blk = (w < 4) ? c8 * 4 + w : 63 - (c8 * 4 + (w - 4));
                const int b = bh >> 2, h = bh & 3; const bf16* Ub = UPO + (size_t)b * SEQ * UPN;
                FaSrc S{Ub + h * 96, UPN, Ub + 384 + h * 128, UPN, PROJ + (size_t)b * SEQ * INP + O_BKR, INP, Ub + 384 + h * 128 + 64, UPN};
                fa_unit<6, 4, 0>(S, blk * 32, vt, MIX + (size_t)b * SEQ * D + 384 + h * 64, mix_gain + 384 + h * 64, nullptr, lane);
            }
            _Pragma("unroll 1") for (int rep = 0; rep < DUP_RET; ++rep)
            if ((gwp & 7) < 4) { const int vc = gwp >> 3;
              for (int i = 0; i < 3; ++i) { const int g = 3 * vc + i; if (g >= 768) break;
                const int bh = g >> 4, n = g & 15, j = gwp & 3, b = bh / 6, h = bh % 6; const bf16* Pb = PROJ + (size_t)b * SEQ * INP;
                FaSrc S{Pb + O_CQ + h * 32, INP, Pb + O_CK + h * 32, INP, nullptr, 0, Pb + O_CV + h * 64, INP};
                ret_pass2(S, n, j, (const LAS char*)(lds + 65536 + i * 5120), vt, MIX + (size_t)b * SEQ * D + 640 + h * 64, mix_gain + 640 + h * 64, Pb + O_CG + h * 64, lane); } }
        }
        SEAM(sb + 2);
        if (PHM(6) && IN(sb + 3)) {
            float* out = LDOUT(); const float* x_in = LDF(0);
            pg8::Gemm g{(const bf16*)LDWS(WS_MIX), (const bf16*)LDWS(WS_WOUT) + (size_t)l * D * D}; pg8::StaticOrder<D> S; S.init(G, FRESH_S(bx));
            pg8::EpiRes E{l == 0 ? x_in : (const float*)out, out, (const float*)LDWS(WS_MOD) + (size_t)l * BATCH * MODW + 2 * D};
            pg8::gemm_phase<pg8::EpiRes, pg8::StaticOrder<D>, true, D, D>(lds, g, S, E, wave);
        }
        SEAM(sb + 3);
        if (PHM(7) && IN(sb + 4)) _Pragma("unroll 1") for (int rep = 0; rep < DUP_LN2; ++rep) ln_rows(FRESH_S(gw), ngw, FRESH_LANE(), LDOUT(), LDF(14) + l * D, (const float*)LDWS(WS_MOD) + (size_t)l * BATCH * MODW, 3, 4, (bf16*)LDWS(WS_XN), nullptr);
        SEAM(sb + 4);
        if (PHM(8) && IN(sb + 5)) {
            pg8::Gemm g{(const bf16*)LDWS(WS_XN), (const bf16*)LDWS(WS_WGU) + (size_t)l * GU * D}; pg8::StaticOrder<GU> S; S.init(G, FRESH_S(bx));
            pg8::EpiSwiGLU E{(bf16*)LDWS(WS_PROJ)};
            _Pragma("unroll 1") for (int rep = 0; rep < DUP_GU; ++rep)
            pg8::gemm_phase<pg8::EpiSwiGLU, pg8::StaticOrder<GU>, true, D, D>(lds, g, S, E, wave);
        }
        SEAM(sb + 5);
        if (PHM(9) && IN(sb + 6)) {
            float* out = LDOUT();
            pg8::Gemm g{(const bf16*)LDWS(WS_PROJ), (const bf16*)LDWS(WS_WDN) + (size_t)l * D * FFH}; pg8::StaticOrder<D> S; S.init(G, FRESH_S(bx));
            pg8::EpiRes E{out, out, (const float*)LDWS(WS_MOD) + (size_t)l * BATCH * MODW + 5 * D};
            pg8::gemm_phase<pg8::EpiRes, pg8::StaticOrder<D>, true, FFH, FFH>(lds, g, S, E, wave);
        }
        SEAM(sb + 6);
        if (PHM(10) && IN(sb + 7)) {
            const int lane = FRESH_LANE(), gwp = FRESH_S(gw);
            float* out = LDOUT();
            if (l + 1 < DEPTH) ln_rows(gwp, ngw, lane, out, LDF(6) + (l + 1) * D, (const float*)LDWS(WS_MOD) + (size_t)(l + 1) * BATCH * MODW, 0, 1, (bf16*)LDWS(WS_XN), nullptr);
            else ln_rows(gwp, ngw, lane, out, LDF(18), nullptr, 0, 0, nullptr, out);
        }
        if (sb + 8 < NSTEPS) SEAM(sb + 7);
    }
#undef IN
#undef SEAM
}

extern "C" void kernel_launch(void* const* d_in, const int* in_sizes, int n_in, void* d_out, int out_size, void* d_ws, size_t ws_size, hipStream_t stream) {
    static int grid = 0;
    if (grid == 0) {
        if (n_in != 19 || out_size != M * D || ws_size < WS_END) { fprintf(stderr, "kernel_launch: unexpected shapes (n_in %d out %d ws %zu need %zu)\n", n_in, out_size, ws_size, (size_t)WS_END); grid = -1; return; }
        int dev = 0, cus = 0, per_cu = 0;
        if (hipGetDevice(&dev) != hipSuccess || hipDeviceGetAttribute(&cus, hipDeviceAttributeMultiprocessorCount, dev) != hipSuccess) { grid = -1; return; }
        if (hipFuncSetAttribute((const void*)fwd, hipFuncAttributeMaxDynamicSharedMemorySize, LDS_BYTES) != hipSuccess) { fprintf(stderr, "kernel_launch: hipFuncSetAttribute failed\n"); grid = -1; return; }
        if (hipOccupancyMaxActiveBlocksPerMultiprocessor(&per_cu, (const void*)fwd, NWAVES * 64, LDS_BYTES) != hipSuccess || per_cu < 1) fprintf(stderr, "kernel_launch: occupancy query reports %d\n", per_cu);
        (void)hipGetLastError();
        grid = cus;
    }
    if (grid < 0) return;
    if (hipMemsetAsync((char*)d_ws + WS_CTL, 0, CTL_ZERO_BYTES, stream) != hipSuccess) return;
    Args a{};
    for (int i = 0; i < 19; ++i) a.in[i] = (const float*)d_in[i];
    a.out = (float*)d_out; a.ws = (unsigned char*)d_ws;
    if (MK_N_LAUNCHES == 1) { a.st_lo = 0; a.st_hi = NSTEPS; hipLaunchKernelGGL(fwd, dim3(grid), dim3(NWAVES * 64), LDS_BYTES, stream, a); }
    else for (int s = 0; s < NSTEPS; ++s) { a.st_lo = s; a.st_hi = s + 1; hipLaunchKernelGGL(fwd, dim3(grid), dim3(NWAVES * 64), LDS_BYTES, stream, a); }
    const hipError_t le = hipPeekAtLastError();
    if (le != hipSuccess) fprintf(stderr, "kernel_launch: launch failed: %s\n", hipGetErrorName(le));
}
```

```cpp
#include <hip/hip_runtime.h>
#include <cstdio>
#include <cstdint>
#include <cmath>

#define LAS __attribute__((address_space(3)))
#define GAS __attribute__((address_space(1)))
#ifndef MK_N_LAUNCHES
#define MK_N_LAUNCHES 1
#endif

typedef unsigned short bf16;
#define FRESH_LANE() ({ int l_; asm volatile("v_mbcnt_lo_u32_b32 %0, -1, 0\n\tv_mbcnt_hi_u32_b32 %0, -1, %0" : "=v"(l_)); l_; })
typedef short bf16x8 __attribute__((ext_vector_type(8)));
typedef short s16x4 __attribute__((ext_vector_type(4)));
typedef float f32x2 __attribute__((ext_vector_type(2)));
typedef float f32x4 __attribute__((ext_vector_type(4)));
typedef float f32x16 __attribute__((ext_vector_type(16)));
typedef unsigned u32x2 __attribute__((ext_vector_type(2)));
typedef unsigned u32x4 __attribute__((ext_vector_type(4)));

constexpr int D = 1024, BATCH = 8, SEQ = 2048, DEPTH = 4, M = BATCH * SEQ;
constexpr int INW = 2720, INP = 2816, FFH = 2816, GU = 2 * FFH, UPK = 384, UPN = 1024, MODW = 6 * D;
constexpr int O_AQ = 0, O_AK = 384, O_AV = 768, O_BQ = 1152, O_BKR = 1536, O_CQ = 1568, O_CK = 1760, O_CV = 1952, O_CG = 2336;
constexpr float EPS = 1e-6f, LOG2E = 1.4426950408889634f;
constexpr float NEG_INF = -__builtin_huge_valf();

__device__ const unsigned char BUCKET[3][129] = {
 {0, 1, 2, 3, 4, 5, 6, 7, 8, 9, 10, 11, 12, 13, 14, 15, 16, 16, 16, 16, 16, 16, 17, 17, 17, 17, 17, 17, 17, 17, 18, 18, 18, 18, 18, 18, 18, 18, 18, 18, 19, 19, 19, 19, 19, 19, 19, 19, 19, 19, 19, 19, 19, 19, 20, 20, 20, 20, 20, 20, 20, 20, 20, 20, 20, 20, 20, 20, 20, 20, 20, 20, 20, 21, 21, 21, 21, 21, 21, 21, 21, 21, 21, 21, 21, 21, 21, 21, 21, 21, 21, 21, 21, 21, 21, 21, 21, 21, 21, 22, 22, 22, 22, 22, 22, 22, 22, 22, 22, 22, 22, 22, 22, 22, 22, 22, 22, 22, 22, 22, 22, 22, 22, 22, 22, 22, 22, 22, 22},
 {0, 4, 8, 12, 16, 16, 17, 17, 18, 18, 19, 19, 19, 19, 20, 20, 20, 20, 20, 21, 21, 21, 21, 21, 21, 22, 22, 22, 22, 22, 22, 22, 22, 22, 23, 23, 23, 23, 23, 23, 23, 23, 23, 23, 23, 23, 24, 24, 24, 24, 24, 24, 24, 24, 24, 24, 24, 24, 24, 24, 24, 24, 25, 25, 25, 25, 25, 25, 25, 25, 25, 25, 25, 25, 25, 25, 25, 25, 25, 25, 25, 25, 25, 26, 26, 26, 26, 26, 26, 26, 26, 26, 26, 26, 26, 26, 26, 26, 26, 26, 26, 26, 26, 26, 26, 26, 26, 26, 26, 26, 26, 26, 26, 27, 27, 27, 27, 27, 27, 27, 27, 27, 27, 27, 27, 27, 27, 27, 27},
 {0, 16, 18, 19, 20, 21, 21, 22, 22, 23, 23, 23, 24, 24, 24, 24, 25, 25, 25, 25, 25, 26, 26, 26, 26, 26, 26, 26, 26, 27, 27, 27, 27, 27, 27, 27, 27, 27, 27, 28, 28, 28, 28, 28, 28, 28, 28, 28, 28, 28, 28, 28, 29, 29, 29, 29, 29, 29, 29, 29, 29, 29, 29, 29, 29, 29, 29, 29, 29, 29, 30, 30, 30, 30, 30, 30, 30, 30, 30, 30, 30, 30, 30, 30, 30, 30, 30, 30, 30, 30, 30, 30, 30, 30, 30, 31, 31, 31, 31, 31, 31, 31, 31, 31, 31, 31, 31, 31, 31, 31, 31, 31, 31, 31, 31, 31, 31, 31, 31, 31, 31, 31, 31, 31, 31, 31, 31, 31, 31}};
__device__ const float INV_FREQ[16] = {0x1.0000000000000p+0f, 0x1.1feb340000000p-1f, 0x1.43d1360000000p-2f, 0x1.6c310e0000000p-3f, 0x1.99999a0000000p-4f, 0x1.ccab840000000p-5f, 0x1.030dc60000000p-5f, 0x1.235a720000000p-6f, 0x1.47ae140000000p-7f, 0x1.7089380000000p-8f, 0x1.9e7c700000000p-9f, 0x1.d22a500000000p-10f, 0x1.0624de0000000p-10f, 0x1.26d42c0000000p-11f, 0x1.4b96c00000000p-12f, 0x1.74eea60000000p-13f};
__device__ const float LOG_G[6] = {-0x1.0415d80000000p-5f, -0x1.0205660000000p-6f, -0x1.0101580000000p-7f, -0x1.0080560000000p-8f, -0x1.0040160000000p-9f, -0x1.0020060000000p-10f};

__device__ __forceinline__ unsigned cvtpk(float lo, float hi) { typedef __bf16 b2 __attribute__((ext_vector_type(2))); f32x2 v = {lo, hi}; b2 b = __builtin_convertvector(v, b2); return __builtin_bit_cast(unsigned, b); }
__device__ __forceinline__ float bf2f(unsigned short b) { return __uint_as_float((unsigned)b << 16); }
__device__ __forceinline__ float ex2(float x) { return __builtin_amdgcn_exp2f(x); }
__device__ __forceinline__ float silu_fast(float v) { return v * __builtin_amdgcn_rcpf(1.f + ex2(-v * LOG2E)); }
__device__ __forceinline__ float wave_sum(float v) {
#pragma unroll
    for (int o = 1; o < 64; o <<= 1) v += __shfl_xor(v, o);
    return v;
}
__device__ __forceinline__ float xmax32(float v) { auto r = __builtin_amdgcn_permlane32_swap(__float_as_uint(v), __float_as_uint(v), false, false); return fmaxf(__uint_as_float(r[0]), __uint_as_float(r[1])); }
__device__ __forceinline__ float xsum32(float v) { auto r = __builtin_amdgcn_permlane32_swap(__float_as_uint(v), __float_as_uint(v), false, false); return __uint_as_float(r[0]) + __uint_as_float(r[1]); }
__device__ __forceinline__ float xmax16(float v) { auto r = __builtin_amdgcn_permlane16_swap(__float_as_uint(v), __float_as_uint(v), false, false); return fmaxf(__uint_as_float(r[0]), __uint_as_float(r[1])); }
__device__ __forceinline__ float xsum16(float v) { auto r = __builtin_amdgcn_permlane16_swap(__float_as_uint(v), __float_as_uint(v), false, false); return __uint_as_float(r[0]) + __uint_as_float(r[1]); }
__device__ __forceinline__ int crow(int r, int hi) { return (r & 3) + 8 * (r >> 2) + 4 * hi; }
typedef short v4i16_t __attribute__((ext_vector_type(4)));
__device__ __forceinline__ s16x4 trrd(const LAS char* p) { return __builtin_bit_cast(s16x4, __builtin_amdgcn_ds_read_tr16_b64_v4i16((LAS v4i16_t*)p)); }

namespace pg8 {
typedef unsigned short bf16_t;
constexpr int BM = 256, BK = 64, HALF = 128, HTB = HALF * BK * 2, STAGE_BYTES = 8 * HTB, NXCD = 8, WGM = 8;
__host__ __device__ __forceinline__ int lds_byte(int r, int c) { const int st = (r >> 4) * 2 + (c >> 5), rr = r & 15, cc = c & 31, ob = rr * 64 + cc * 2; return st * 1024 + (ob ^ (((ob >> 9) & 1) << 5)); }
__host__ __device__ __forceinline__ void stage_rc(int b, int& R, int& C) { const int st = b / 1024, sb = b % 1024, swz = sb ^ (((sb >> 9) & 1) << 5); R = (st >> 1) * 16 + swz / 64; C = (st & 1) * 32 + (swz % 64) / 2; }
__host__ __device__ __forceinline__ int perm32(int rho) { const int n = rho >> 4, i = rho & 15; return 8 * (i >> 2) + 4 * n + (i & 3); }
struct Unit { int pm, pn; };
struct Gemm { const bf16_t* A; const bf16_t* Bt; };
template <int N_>
struct StaticOrder {
    static constexpr int nM = 64, nN = N_ / BM, nwg = nM * nN;
    int G, c;
    __host__ __device__ void init(int G_, int c_) { G = G_; c = c_; }
    __host__ __device__ bool next(int i, Unit& u) const {
        const long L = (long)i * G + c; if (L >= nwg) return false;
        int wgid = (int)L; { const int q = nwg / NXCD, r = nwg % NXCD, xcd = wgid % NXCD, off = wgid / NXCD; wgid = (xcd < r ? xcd * (q + 1) : r * (q + 1) + (xcd - r) * q) + off; }
        const int nig = WGM * nN, gid = wgid / nig, fm = gid * WGM, gsz = (nM - fm) < WGM ? (nM - fm) : WGM;
        u.pm = fm + ((wgid % nig) % gsz); u.pn = (wgid % nig) / gsz; return true;
    }
};

template <class Epi, class Sched, bool ALIGN_EPI, int K, int lda>
__device__ __forceinline__ void gemm_phase(LAS unsigned char* lds, const Gemm g, const Sched& S, const Epi& E, const int wid_in) {
    int wid = wid_in; asm volatile("" : "+s"(wid));
    const int lane = FRESH_LANE(), tid = wid * 64 + lane;
    const int wr = wid >> 2, wc = wid & 3, fr = lane & 15, fq = lane >> 4;
    constexpr int nt = K / BK;
    unsigned voffA[2], voffB[2];
#pragma unroll
    for (int i = 0; i < 2; ++i) { int R, C; stage_rc(tid * 16 + i * 8192, R, C); const int Rb = Epi::PERM ? ((R & ~31) + perm32(R & 31)) : R;
        voffA[i] = (unsigned)(R * lda + C) * 2u; voffB[i] = (unsigned)(Rb * K + C) * 2u; }
    constexpr size_t kstep = (size_t)(BK * 2);
    constexpr size_t hstepA = (size_t)HALF * lda * 2, hstepB = (size_t)HALF * K * 2;
    constexpr size_t tstepA = 2 * hstepA, tstepB = 2 * hstepB;
    const unsigned ldsw = (unsigned)wid * 1024u;
    const int aoff = lds_byte(wr * 64 + fr, fq * 8), boff = lds_byte(wc * 32 + fr, fq * 8);
#define PG8_SA(b, h) (((b) * 2 + (h)) * HTB)
#define PG8_SB(b, h) ((4 + (b) * 2 + (h)) * HTB)
#define PG8_STAGE(bufoff, gbase, voff) do { _Pragma("unroll") for (int _i = 0; _i < 2; ++_i) \
        __builtin_amdgcn_global_load_lds((const unsigned*)((const char*)(gbase) + (voff)[_i]), (LAS unsigned*)(lds + (bufoff) + ldsw + _i * 8192), 16, 0, 0); } while (0)
#define PG8_LDA(dst, b, h) do { _Pragma("unroll") for (int m = 0; m < 4; ++m) _Pragma("unroll") for (int k = 0; k < 2; ++k) dst[m][k] = *(const LAS bf16x8*)(lds + PG8_SA(b, h) + aoff + m * 2048 + k * 1024); } while (0)
#define PG8_LDB(dst, b, h) do { _Pragma("unroll") for (int n = 0; n < 2; ++n) _Pragma("unroll") for (int k = 0; k < 2; ++k) dst[n][k] = *(const LAS bf16x8*)(lds + PG8_SB(b, h) + boff + n * 2048 + k * 1024); } while (0)
#define PG8_MMA(ai, bj, At, Bt) do { __builtin_amdgcn_s_setprio(1); _Pragma("unroll") for (int m = 0; m < 4; ++m) _Pragma("unroll") for (int n = 0; n < 2; ++n) _Pragma("unroll") for (int k = 0; k < 2; ++k) \
        acc[ai][bj][m][n] = __builtin_amdgcn_mfma_f32_16x16x32_bf16(Bt[n][k], At[m][k], acc[ai][bj][m][n], 0, 0, 0); __builtin_amdgcn_s_setprio(0); } while (0)
#define PG8_WAIT_V(n) asm volatile("s_waitcnt vmcnt(" #n ")" ::: "memory")
#define PG8_WAIT_L(n) asm volatile("s_waitcnt lgkmcnt(" #n ")" ::: "memory")
#define PG8_BAR __builtin_amdgcn_s_barrier()
#define PG8_SCHED __builtin_amdgcn_sched_barrier(0)
    Unit cur, nxt; int ui = 0;
    if (!S.next(0, cur)) return;
    f32x4 acc[2][2][4][2];
#pragma unroll
    for (int a = 0; a < 2; ++a)
#pragma unroll
        for (int b = 0; b < 2; ++b)
#pragma unroll
            for (int m = 0; m < 4; ++m)
#pragma unroll
                for (int n = 0; n < 2; ++n) acc[a][b][m][n] = (f32x4){0.f, 0.f, 0.f, 0.f};
    bf16x8 At[4][2], B0[2][2], B1[2][2];
    const char* cA = (const char*)g.A + (size_t)cur.pm * tstepA; const char* cB = (const char*)g.Bt + (size_t)cur.pn * tstepB;
    PG8_STAGE(PG8_SB(0, 0), cB, voffB); PG8_STAGE(PG8_SB(0, 1), cB + hstepB, voffB); PG8_STAGE(PG8_SA(0, 0), cA, voffA); PG8_STAGE(PG8_SA(0, 1), cA + hstepA, voffA);
    if (wr == 1) PG8_BAR;
    PG8_WAIT_V(2); PG8_BAR;
    PG8_STAGE(PG8_SB(1, 0), cB + kstep, voffB); PG8_STAGE(PG8_SA(1, 0), cA + kstep, voffA); PG8_STAGE(PG8_SB(1, 1), cB + hstepB + kstep, voffB);
    PG8_WAIT_V(6); PG8_BAR;
    for (;;) {
        const bool has_next = S.next(ui + 1, nxt);
        const char* nA = has_next ? (const char*)g.A + (size_t)nxt.pm * tstepA : cA; const char* nB = has_next ? (const char*)g.Bt + (size_t)nxt.pn * tstepB : cB;
        for (int t = 0; t < nt; t += 2) {
            const bool last = (t == nt - 2);
            const char* a1 = cA + (size_t)(t + 1) * kstep;
            const char* a2 = last ? nA : cA + (size_t)(t + 2) * kstep; const char* b2 = last ? nB : cB + (size_t)(t + 2) * kstep;
            const char* a3 = a2 + kstep; const char* b3 = b2 + kstep;
            PG8_LDB(B0, 0, 0); PG8_LDB(B1, 0, 1); PG8_SCHED; PG8_LDA(At, 0, 0); PG8_STAGE(PG8_SA(1, 1), a1 + hstepA, voffA);
            PG8_WAIT_V(8); PG8_WAIT_L(0); PG8_BAR; PG8_MMA(0, 0, At, B0); PG8_MMA(0, 1, At, B1); PG8_BAR; PG8_SCHED;
            PG8_LDA(At, 0, 1); PG8_STAGE(PG8_SB(0, 0), b2, voffB); PG8_STAGE(PG8_SB(0, 1), b2 + hstepB, voffB); PG8_STAGE(PG8_SA(0, 0), a2, voffA);
            PG8_WAIT_V(8); PG8_WAIT_L(0); PG8_BAR; PG8_MMA(1, 0, At, B0); PG8_MMA(1, 1, At, B1); PG8_BAR; PG8_SCHED;
            PG8_LDB(B0, 1, 0); PG8_LDB(B1, 1, 1); PG8_SCHED; PG8_LDA(At, 1, 0); PG8_STAGE(PG8_SA(0, 1), a2 + hstepA, voffA);
            PG8_WAIT_V(8); PG8_WAIT_L(0); PG8_BAR; PG8_MMA(0, 0, At, B0); PG8_MMA(0, 1, At, B1); PG8_BAR; PG8_SCHED;
            PG8_LDA(At, 1, 1); PG8_STAGE(PG8_SB(1, 0), b3, voffB); PG8_STAGE(PG8_SB(1, 1), b3 + hstepB, voffB); PG8_STAGE(PG8_SA(1, 0), a3, voffA);
            PG8_WAIT_V(8); PG8_WAIT_L(0); PG8_BAR; PG8_MMA(1, 0, At, B0); PG8_MMA(1, 1, At, B1); PG8_BAR; PG8_SCHED;
        }
        if constexpr (ALIGN_EPI) { if (wr == 0) PG8_BAR; }
        E(acc, cur, wr, wc, fr, fq);
        if (!has_next) break;
#pragma unroll
        for (int a = 0; a < 2; ++a)
#pragma unroll
            for (int b = 0; b < 2; ++b)
#pragma unroll
                for (int m = 0; m < 4; ++m)
#pragma unroll
                    for (int n = 0; n < 2; ++n) acc[a][b][m][n] = (f32x4){0.f, 0.f, 0.f, 0.f};
        cur = nxt; cA = nA; cB = nB; ++ui;
        if constexpr (ALIGN_EPI) { if (wr == 1) PG8_BAR; }
    }
    PG8_WAIT_V(0);
    if constexpr (!ALIGN_EPI) { if (wr == 0) PG8_BAR; }
    PG8_BAR;
#undef PG8_SA
#undef PG8_SB
#undef PG8_STAGE
#undef PG8_LDA
#undef PG8_LDB
#undef PG8_MMA
#undef PG8_WAIT_V
#undef PG8_WAIT_L
#undef PG8_BAR
#undef PG8_SCHED
}

__device__ __forceinline__ void rope8(f32x4& v0, f32x4& v1, const float* ropec, const float* ropes, int row, int fq) {
    f32x4 p0, p1;
#pragma unroll
    for (int j = 0; j < 4; ++j) { p0[j] = __shfl_xor(v0[j], 32); p1[j] = __shfl_xor(v1[j], 32); }
    const float* cr = ropec + (size_t)row * 16 + 8 * (fq & 1); const float* sr = ropes + (size_t)row * 16 + 8 * (fq & 1);
    const f32x4 c0 = *(const f32x4*)cr, c1 = *(const f32x4*)(cr + 4), s0 = *(const f32x4*)sr, s1 = *(const f32x4*)(sr + 4);
    const float sg = (fq >> 1) ? 1.f : -1.f;
    v0 = v0 * c0 + p0 * s0 * sg; v1 = v1 * c1 + p1 * s1 * sg;
}
__device__ __forceinline__ void store8(bf16_t* p, f32x4 v0, f32x4 v1) { u32x4 w; w.x = cvtpk(v0[0], v0[1]); w.y = cvtpk(v0[2], v0[3]); w.z = cvtpk(v1[0], v1[1]); w.w = cvtpk(v1[2], v1[3]); *(u32x4*)p = w; }

struct EpiInProj {
    static constexpr bool PERM = true;
    bf16_t* O; float* ssp; const float* ropec; const float* ropes;
    __device__ __forceinline__ void operator()(const f32x4 (&acc)[2][2][4][2], const Unit& u, int wr, int wc, int fr, int fq) const {
        { const int ln_ = FRESH_LANE(); fr = ln_ & 15; fq = ln_ >> 4; }
#pragma unroll
        for (int bj = 0; bj < 2; ++bj) {
            const int g = u.pn * 8 + bj * 4 + wc;
            if (g >= 85) continue;
            const int col0 = g * 32 + 8 * fq;
#pragma unroll
            for (int ai = 0; ai < 2; ++ai)
#pragma unroll
                for (int m = 0; m < 4; ++m) {
                    const int row = u.pm * BM + ai * HALF + wr * 64 + m * 16 + fr;
                    f32x4 v0 = acc[ai][bj][m][0], v1 = acc[ai][bj][m][1];
                    if (g < 12) { v0 = v0 * (0.125f * LOG2E); v1 = v1 * (0.125f * LOG2E); }
                    else if (g >= 36 && g < 48) {
                        float ss = (v0[0] * v0[0] + v0[1] * v0[1]) + (v0[2] * v0[2] + v0[3] * v0[3]) + (v1[0] * v1[0] + v1[1] * v1[1]) + (v1[2] * v1[2] + v1[3] * v1[3]);
                        ss += __shfl_xor(ss, 16); ss += __shfl_xor(ss, 32);
                        if (fq == 0) ssp[(size_t)row * 12 + (g - 36)] = ss;
                    } else if (g >= 48 && g < 61) {
                        rope8(v0, v1, ropec, ropes, row, fq);
                        if (g >= 49) {
                            const int t = row & (SEQ - 1); const bool isk = g >= 55; const int hh = isk ? g - 55 : g - 49;
                            const float e = (float)(isk ? 1024 - t : t - 1024) * (LOG_G[hh] * LOG2E);
                            const float sc = ex2(e) * (isk ? 0.17677669529663687f : 1.f);
                            v0 = v0 * sc; v1 = v1 * sc;
                        }
                    }
                    store8(O + (size_t)row * INP + col0, v0, v1);
                    asm volatile("" ::: "memory");
                }
        }
    }
};
struct EpiUp {
    static constexpr bool PERM = true;
    bf16_t* O; const float* ssp; const float* ropec; const float* ropes;
    __device__ __forceinline__ void operator()(const f32x4 (&acc)[2][2][4][2], const Unit& u, int wr, int wc, int fr, int fq) const {
        { const int ln_ = FRESH_LANE(); fr = ln_ & 15; fq = ln_ >> 4; }
#pragma unroll
        for (int ai = 0; ai < 2; ++ai)
#pragma unroll
            for (int m = 0; m < 4; ++m) {
                asm volatile("" ::: "memory");
                const int row = u.pm * BM + ai * HALF + wr * 64 + m * 16 + fr;
                const f32x4 a0 = *(const f32x4*)(ssp + (size_t)row * 12), a1 = *(const f32x4*)(ssp + (size_t)row * 12 + 4), a2 = *(const f32x4*)(ssp + (size_t)row * 12 + 8);
                const float sq = ((a0[0] + a0[1]) + (a0[2] + a0[3])) + ((a1[0] + a1[1]) + (a1[2] + a1[3])), skv = (a2[0] + a2[1]) + (a2[2] + a2[3]);
                const float rq = rsqrtf(sq * (1.f / 256.f) + EPS) * (0.10206207261596575f * LOG2E), rkv = rsqrtf(skv * (1.f / 128.f) + EPS);
#pragma unroll
                for (int bj = 0; bj < 2; ++bj) {
                    const int g = u.pn * 8 + bj * 4 + wc;
                    if (g >= 28) continue;
                    f32x4 v0 = acc[ai][bj][m][0], v1 = acc[ai][bj][m][1];
                    if (g < 12) { if ((g % 3) == 2) rope8(v0, v1, ropec, ropes, row, fq); v0 = v0 * rq; v1 = v1 * rq; }
                    else { v0 = v0 * rkv; v1 = v1 * rkv; }
                    store8(O + (size_t)row * UPN + g * 32 + 8 * fq, v0, v1);
                }
            }
    }
};
struct EpiRes {
    static constexpr bool PERM = false;
    const float* res; float* out; const float* gate;
    __device__ __forceinline__ void operator()(const f32x4 (&acc)[2][2][4][2], const Unit& u, int wr, int wc, int fr, int fq) const {
        { const int ln_ = FRESH_LANE(); fr = ln_ & 15; fq = ln_ >> 4; }
        const int col0 = u.pn * BM + wc * 32 + 4 * fq; const float* gp = gate + (size_t)(u.pm >> 3) * MODW + col0;
        f32x4 gv[2][2];
#pragma unroll
        for (int bj = 0; bj < 2; ++bj)
#pragma unroll
            for (int n = 0; n < 2; ++n) gv[bj][n] = *(const f32x4*)(gp + bj * HALF + n * 16);
#pragma unroll
        for (int ai = 0; ai < 2; ++ai)
#pragma unroll
            for (int m = 0; m < 4; ++m) { const size_t off = (size_t)(u.pm * BM + ai * HALF + wr * 64 + m * 16 + fr) * D + col0;
#pragma unroll
                for (int bj = 0; bj < 2; ++bj)
#pragma unroll
                    for (int n = 0; n < 2; ++n) { const f32x4 r = *(const f32x4*)(res + off + bj * HALF + n * 16); *(f32x4*)(out + off + bj * HALF + n * 16) = r + gv[bj][n] * acc[ai][bj][m][n]; }
                if (m & 1) asm volatile("" ::: "memory"); }
    }
};
struct EpiSwiGLU {
    static constexpr bool PERM = true;
    bf16_t* O;
    __device__ __forceinline__ void operator()(const f32x4 (&acc)[2][2][4][2], const Unit& u, int wr, int wc, int fr, int fq) const {
        { const int ln_ = FRESH_LANE(); fr = ln_ & 15; fq = ln_ >> 4; }
        const int col0 = u.pn * HALF + wc * 32 + 8 * fq;
#pragma unroll
        for (int ai = 0; ai < 2; ++ai)
#pragma unroll
            for (int m = 0; m < 4; ++m) { const int row = u.pm * BM + ai * HALF + wr * 64 + m * 16 + fr;
                f32x4 v0, v1;
#pragma unroll
                for (int j = 0; j < 4; ++j) { v0[j] = silu_fast(acc[ai][0][m][0][j]) * acc[ai][1][m][0][j]; v1[j] = silu_fast(acc[ai][0][m][1][j]) * acc[ai][1][m][1][j]; }
                store8(O + (size_t)row * FFH + col0, v0, v1); }
    }
};
}

__device__ __forceinline__ int vt_chunk_off(int key, int c) { return (c >> 2) * 2048 + key * 64 + (((c & 3) ^ (((key >> 3) & 1) << 1)) << 4); }
__device__ __forceinline__ void vt_stage(LAS char* vt, const u32x4 (&vr)[4], int lane) {
#pragma unroll
    for (int e = 0; e < 4; ++e) *(LAS u32x4*)(vt + vt_chunk_off(8 * e + (lane >> 3), lane & 7)) = vr[e];
}

struct FaSrc { const bf16* q; int ldq; const bf16* k1; int ldk1; const bf16* k2; int ldk2; const bf16* v; int ldv; };
template <int NKS, int NKS1>
__device__ __forceinline__ void fa_load(bf16x8 (&kf)[NKS], u32x4 (&vr)[4], const FaSrc& S, int k0, int lane) {
    const int r = lane & 31, h = lane >> 5;
#pragma unroll
    for (int s = 0; s < NKS; ++s) {
        const bf16* p = (s < NKS1) ? S.k1 + (size_t)(k0 + r) * S.ldk1 + 16 * s + 8 * h : S.k2 + (size_t)(k0 + r) * S.ldk2 + 16 * (s - NKS1) + 8 * h;
        kf[s] = *(const bf16x8*)p; }
#pragma unroll
    for (int e = 0; e < 4; ++e) vr[e] = *(const u32x4*)(S.v + (size_t)(k0 + 8 * e + (lane >> 3)) * S.ldv + 8 * (lane & 7));
}
template <int NKS, bool SOFTMAX>
__device__ __forceinline__ void fa_tile(const bf16x8 (&kf)[NKS], const u32x4 (&vr)[4], const bf16x8 (&qf)[NKS], f32x16 (&O)[2], float& m, float& l, LAS char* vt, int k0, int q0, bool diag, int lane) {
    const int r = lane & 31, h = lane >> 5;
    vt_stage(vt, vr, lane);
    f32x16 S;
#pragma unroll
    for (int i = 0; i < 16; ++i) S[i] = 0.f;
#pragma unroll
    for (int s = 0; s < NKS; ++s) S = __builtin_amdgcn_mfma_f32_32x32x16_bf16(kf[s], qf[s], S, 0, 0, 0);
    if (diag) {
#pragma unroll
        for (int i = 0; i < 16; ++i) if (k0 + crow(i, h) > q0 + r) S[i] = SOFTMAX ? NEG_INF : 0.f;
    }
    if (SOFTMAX) {
        float mx = S[0];
#pragma unroll
        for (int i = 1; i < 16; ++i) mx = fmaxf(mx, S[i]);
        mx = xmax32(mx);
        const float mn = fmaxf(m, mx), ms = (mn == NEG_INF) ? 0.f : mn, alpha = ex2(m - ms);
        m = mn; l *= alpha;
#pragma unroll
        for (int i = 0; i < 16; ++i) { O[0][i] *= alpha; O[1][i] *= alpha; }
        float sum = 0.f;
#pragma unroll
        for (int i = 0; i < 16; ++i) { S[i] = ex2(S[i] - ms); sum += S[i]; }
        l += sum;
    }
    bf16x8 pf[2];
#pragma unroll
    for (int s2 = 0; s2 < 2; ++s2) { u32x4 w; w.x = cvtpk(S[8 * s2 + 0], S[8 * s2 + 1]); w.y = cvtpk(S[8 * s2 + 2], S[8 * s2 + 3]); w.z = cvtpk(S[8 * s2 + 4], S[8 * s2 + 5]); w.w = cvtpk(S[8 * s2 + 6], S[8 * s2 + 7]); pf[s2] = __builtin_bit_cast(bf16x8, w); }
    const int g16 = (lane >> 4) & 1, q = (lane & 15) >> 2, p = lane & 3;
    const int ch = 2 * g16 + (p >> 1);
    const LAS char* blo = vt + (4 * h + q) * 64 + (ch << 4) + (p & 1) * 8;
    const LAS char* bhi = vt + (8 + 4 * h + q) * 64 + ((ch ^ 2) << 4) + (p & 1) * 8;
#pragma unroll
    for (int vb = 0; vb < 2; ++vb)
#pragma unroll
        for (int s2 = 0; s2 < 2; ++s2) {
            const s16x4 lo = trrd(blo + vb * 2048 + s2 * 1024), hi = trrd(bhi + vb * 2048 + s2 * 1024);
            const bf16x8 vf = {lo[0], lo[1], lo[2], lo[3], hi[0], hi[1], hi[2], hi[3]};
            O[vb] = __builtin_amdgcn_mfma_f32_32x32x16_bf16(vf, pf[s2], O[vb], 0, 0, 0);
        }
}
template <int NKS, int NKS1, int MODE>
__device__ __forceinline__ void fa_unit(const FaSrc& S, int q0, LAS char* vt, bf16* mixrow0  , const float* gain, const bf16* gate  , int lane) {
    const int r = lane & 31, h = lane >> 5;
    bf16x8 qf[NKS];
#pragma unroll
    for (int s = 0; s < NKS; ++s) qf[s] = *(const bf16x8*)(S.q + (size_t)(q0 + r) * S.ldq + 16 * s + 8 * h);
    f32x16 O[2];
#pragma unroll
    for (int i = 0; i < 16; ++i) { O[0][i] = 0.f; O[1][i] = 0.f; }
    float m = NEG_INF, l = 0.f;
    const int nt = q0 / 32 + 1;
    bf16x8 kfA[NKS], kfB[NKS]; u32x4 vrA[4], vrB[4];
    fa_load<NKS, NKS1>(kfA, vrA, S, 0, lane);
    for (int kt = 0; kt < nt; kt += 2) {
        fa_load<NKS, NKS1>(kfB, vrB, S, (kt + 1 < nt ? kt + 1 : nt - 1) * 32, lane);
        fa_tile<NKS, MODE == 0>(kfA, vrA, qf, O, m, l, vt, kt * 32, q0, kt == nt - 1, lane);
        fa_load<NKS, NKS1>(kfA, vrA, S, (kt + 2 < nt ? kt + 2 : nt - 1) * 32, lane);
        if (kt + 1 < nt) fa_tile<NKS, MODE == 0>(kfB, vrB, qf, O, m, l, vt, (kt + 1) * 32, q0, kt + 1 == nt - 1, lane);
    }
    const size_t tok = (size_t)(q0 + r);
    if (MODE == 0) {
        const float lt = xsum32(l), inv = 1.f / lt;
        float ss = 0.f;
#pragma unroll
        for (int vb = 0; vb < 2; ++vb)
#pragma unroll
            for (int i = 0; i < 16; ++i) { O[vb][i] *= inv; ss += O[vb][i] * O[vb][i]; }
        ss = xsum32(ss);
        const float rs = rsqrtf(ss * (1.f / 64.f) + EPS);
#pragma unroll
        for (int vb = 0; vb < 2; ++vb)
#pragma unroll
            for (int g = 0; g < 4; ++g) { const int d0 = 32 * vb + 8 * g + 4 * h; const f32x4 gn = *(const f32x4*)(gain + d0);
                u32x2 w; w.x = cvtpk(O[vb][4 * g] * rs * gn[0], O[vb][4 * g + 1] * rs * gn[1]); w.y = cvtpk(O[vb][4 * g + 2] * rs * gn[2], O[vb][4 * g + 3] * rs * gn[3]);
                *(u32x2*)(mixrow0 + tok * D + d0) = w; }
    } else {
        float su = 0.f;
#pragma unroll
        for (int vb = 0; vb < 2; ++vb)
#pragma unroll
            for (int i = 0; i < 16; ++i) su += O[vb][i];
        su = xsum32(su);
        const float mu = su * (1.f / 64.f); float var = 0.f;
#pragma unroll
        for (int vb = 0; vb < 2; ++vb)
#pragma unroll
            for (int i = 0; i < 16; ++i) { O[vb][i] -= mu; var += O[vb][i] * O[vb][i]; }
        var = xsum32(var);
        const float rs = rsqrtf(var * (1.f / 64.f) + EPS);
#pragma unroll
        for (int vb = 0; vb < 2; ++vb)
#pragma unroll
            for (int g = 0; g < 4; ++g) { const int d0 = 32 * vb + 8 * g + 4 * h; const f32x4 gn = *(const f32x4*)(gain + d0);
                const u32x2 gb = *(const u32x2*)(gate + tok * INP + d0);
                const float g0 = silu_fast(__uint_as_float(gb.x << 16)), g1 = silu_fast(__uint_as_float(gb.x & 0xffff0000u)), g2 = silu_fast(__uint_as_float(gb.y << 16)), g3 = silu_fast(__uint_as_float(gb.y & 0xffff0000u));
                u32x2 w; w.x = cvtpk(O[vb][4 * g] * rs * gn[0] * g0, O[vb][4 * g + 1] * rs * gn[1] * g1); w.y = cvtpk(O[vb][4 * g + 2] * rs * gn[2] * g2, O[vb][4 * g + 3] * rs * gn[3] * g3);
                *(u32x2*)(mixrow0 + tok * D + d0) = w; }
    }
}

__device__ __forceinline__ void ret_pass1(const bf16* Pb  , int h, int n, float* GTu  , LAS char* kt, LAS char* vt, int lane) {
    const int q4 = lane >> 4, q = (lane & 15) >> 2, pp = lane & 3, sw = (q4 & 1) << 1;
    f32x4 acc[2][4];
#pragma unroll
    for (int mb = 0; mb < 2; ++mb)
#pragma unroll
        for (int nb = 0; nb < 4; ++nb) acc[mb][nb] = (f32x4){0.f, 0.f, 0.f, 0.f};
    const bf16* kp = Pb + (size_t)(128 * n) * INP + O_CK + h * 32; const bf16* vp = Pb + (size_t)(128 * n) * INP + O_CV + h * 64;
    u32x4 kr[2], vr[4];
#pragma unroll
    for (int e = 0; e < 2; ++e) kr[e] = *(const u32x4*)(kp + (size_t)(16 * e + (lane >> 2)) * INP + 8 * (lane & 3));
#pragma unroll
    for (int e = 0; e < 4; ++e) vr[e] = *(const u32x4*)(vp + (size_t)(8 * e + (lane >> 3)) * INP + 8 * (lane & 7));
#pragma unroll 1
    for (int st = 0; st < 4; ++st) {
#pragma unroll
        for (int e = 0; e < 2; ++e) *(LAS u32x4*)(kt + vt_chunk_off(16 * e + (lane >> 2), lane & 3)) = kr[e];
        vt_stage(vt, vr, lane);
        const int nx = st < 3 ? st + 1 : 3;
#pragma unroll
        for (int e = 0; e < 2; ++e) kr[e] = *(const u32x4*)(kp + (size_t)(32 * nx + 16 * e + (lane >> 2)) * INP + 8 * (lane & 3));
#pragma unroll
        for (int e = 0; e < 4; ++e) vr[e] = *(const u32x4*)(vp + (size_t)(32 * nx + 8 * e + (lane >> 3)) * INP + 8 * (lane & 7));
        const LAS char* kbase = kt + (8 * q4 + q) * 64 + (pp & 1) * 8; const LAS char* vbase = vt + (8 * q4 + q) * 64 + (pp & 1) * 8;
        bf16x8 af[2], bfr[4];
#pragma unroll
        for (int mb = 0; mb < 2; ++mb) { const LAS char* pa = kbase + (((2 * mb + (pp >> 1)) ^ sw) << 4); const s16x4 lo = trrd(pa), hi = trrd(pa + 256); af[mb] = (bf16x8){lo[0], lo[1], lo[2], lo[3], hi[0], hi[1], hi[2], hi[3]}; }
#pragma unroll
        for (int nb = 0; nb < 4; ++nb) { const LAS char* pa = vbase + (nb >> 1) * 2048 + (((2 * (nb & 1) + (pp >> 1)) ^ sw) << 4); const s16x4 lo = trrd(pa), hi = trrd(pa + 256); bfr[nb] = (bf16x8){lo[0], lo[1], lo[2], lo[3], hi[0], hi[1], hi[2], hi[3]}; }
#pragma unroll
        for (int mb = 0; mb < 2; ++mb)
#pragma unroll
            for (int nb = 0; nb < 4; ++nb) acc[mb][nb] = __builtin_amdgcn_mfma_f32_16x16x32_bf16(af[mb], bfr[nb], acc[mb][nb], 0, 0, 0);
    }
#pragma unroll
    for (int mb = 0; mb < 2; ++mb)
#pragma unroll
        for (int nb = 0; nb < 4; ++nb) *(f32x4*)(GTu + (16 * nb + (lane & 15)) * 32 + 16 * mb + 4 * q4) = acc[mb][nb];
}
__device__ __forceinline__ void ret_pass2(const FaSrc& S, int n, int j, const LAS char* fl  , LAS char* vt, bf16* mixrow0, const float* gain, const bf16* gate, int lane) {
    const int r = lane & 31, h = lane >> 5, q0 = 128 * n + 32 * j;
    bf16x8 qf[2];
#pragma unroll
    for (int s = 0; s < 2; ++s) qf[s] = *(const bf16x8*)(S.q + (size_t)(q0 + r) * S.ldq + 16 * s + 8 * h);
    f32x16 O[2];
#pragma unroll
    for (int i = 0; i < 16; ++i) { O[0][i] = 0.f; O[1][i] = 0.f; }
    float m = 0.f, l = 0.f;
    bf16x8 kfA[2], kfB[2]; u32x4 vrA[4], vrB[4];
    const int t0 = 4 * n, nt = j + 1;
    fa_load<2, 2>(kfA, vrA, S, t0 * 32, lane);
#pragma unroll
    for (int vb = 0; vb < 2; ++vb)
#pragma unroll
        for (int s = 0; s < 2; ++s) { const bf16x8 fa = *(const LAS bf16x8*)(fl + (32 * vb + r) * 80 + (2 * s + h) * 16);
            O[vb] = __builtin_amdgcn_mfma_f32_32x32x16_bf16(fa, qf[s], O[vb], 0, 0, 0); }
    for (int kt = 0; kt < nt; kt += 2) {
        fa_load<2, 2>(kfB, vrB, S, (t0 + (kt + 1 < nt ? kt + 1 : nt - 1)) * 32, lane);
        fa_tile<2, false>(kfA, vrA, qf, O, m, l, vt, (t0 + kt) * 32, q0, kt == nt - 1, lane);
        fa_load<2, 2>(kfA, vrA, S, (t0 + (kt + 2 < nt ? kt + 2 : nt - 1)) * 32, lane);
        if (kt + 1 < nt) fa_tile<2, false>(kfB, vrB, qf, O, m, l, vt, (t0 + kt + 1) * 32, q0, kt + 1 == nt - 1, lane);
    }
    const size_t tok = (size_t)(q0 + r);
    float su = 0.f;
#pragma unroll
    for (int vb = 0; vb < 2; ++vb)
#pragma unroll
        for (int i = 0; i < 16; ++i) su += O[vb][i];
    su = xsum32(su);
    const float mu = su * (1.f / 64.f); float var = 0.f;
#pragma unroll
    for (int vb = 0; vb < 2; ++vb)
#pragma unroll
        for (int i = 0; i < 16; ++i) { O[vb][i] -= mu; var += O[vb][i] * O[vb][i]; }
    var = xsum32(var);
    const float rs = rsqrtf(var * (1.f / 64.f) + EPS);
#pragma unroll
    for (int vb = 0; vb < 2; ++vb)
#pragma unroll
        for (int g = 0; g < 4; ++g) { const int d0 = 32 * vb + 8 * g + 4 * h; const f32x4 gn = *(const f32x4*)(gain + d0);
            const u32x2 gb = *(const u32x2*)(gate + tok * INP + d0);
            const float g0 = silu_fast(__uint_as_float(gb.x << 16)), g1 = silu_fast(__uint_as_float(gb.x & 0xffff0000u)), g2 = silu_fast(__uint_as_float(gb.y << 16)), g3 = silu_fast(__uint_as_float(gb.y & 0xffff0000u));
            u32x2 w; w.x = cvtpk(O[vb][4 * g] * rs * gn[0] * g0, O[vb][4 * g + 1] * rs * gn[1] * g1); w.y = cvtpk(O[vb][4 * g + 2] * rs * gn[2] * g2, O[vb][4 * g + 3] * rs * gn[3] * g3);
            *(u32x2*)(mixrow0 + tok * D + d0) = w; }
}

__device__ __forceinline__ void dil_params(int si, int n3, int n2, int s2s, int s1s, int T0, int r, int& kb, int& sh, int& p) {
    if (si < n3) { p = 2; sh = 4; kb = 512 * si + r; }
    else if (si < n3 + n2) { const int s = s2s + (si - n3); p = 1; sh = 2; kb = 4 * ((T0 >> 2) + (r >> 2) - 128 + 32 * s) + (r & 3); }
    else { const int s = s1s + (si - n3 - n2); p = 0; sh = 0; kb = T0 - 128 + 32 * s; }
}
__device__ __forceinline__ int clampi(int v, int lo, int hi) { return v < lo ? lo : (v > hi ? hi : v); }
__device__ __forceinline__ void dil_load(bf16x8 (&kf)[2][2], u32x4 (&vr)[4], __amdgpu_buffer_rsrc_t rs, const int (&kkK)[2], int colK, const int (&kkV)[4], int colV, int kb, int sh) {
#pragma unroll
    for (int a = 0; a < 2; ++a) { const int off = __mul24(kb + (kkK[a] << sh), INP * 2) + colK;
        kf[a][0] = __builtin_bit_cast(bf16x8, __builtin_amdgcn_raw_buffer_load_b128(rs, off, 0, 0)); kf[a][1] = __builtin_bit_cast(bf16x8, __builtin_amdgcn_raw_buffer_load_b128(rs, off + 64, 0, 0)); }
#pragma unroll
    for (int e = 0; e < 4; ++e) vr[e] = __builtin_amdgcn_raw_buffer_load_b128(rs, __mul24(kb + (kkV[e] << sh), INP * 2) + colV, 0, 0);
}
__device__ __forceinline__ void dil_step(const bf16x8 (&kf)[2][2], const u32x4 (&vr)[4], bf16x8 qf0, bf16x8 qf1, f32x4 (&O)[4], float& m, float& l, LAS char* vt, const LAS float* tabR, int kb, int sh, int p, int tq, int lane) {
    const int q4 = lane >> 4;
    vt_stage(vt, vr, lane);
    f32x4 S[2];
#pragma unroll
    for (int a = 0; a < 2; ++a) { S[a] = (f32x4){0.f, 0.f, 0.f, 0.f};
        S[a] = __builtin_amdgcn_mfma_f32_16x16x32_bf16(kf[a][0], qf0, S[a], 0, 0, 0);
        S[a] = __builtin_amdgcn_mfma_f32_16x16x32_bf16(kf[a][1], qf1, S[a], 0, 0, 0); }
    const int jq = (tq - kb) >> sh;
    const LAS float* tb = tabR + p * 640 + 383 - jq + 8 * q4;
    float sc[8];
#pragma unroll
    for (int i = 0; i < 8; ++i) sc[i] = S[i >> 2][i & 3] + tb[i];
    if (kb < 0) {
#pragma unroll
        for (int i = 0; i < 8; ++i) if (kb + ((8 * q4 + i) << sh) < 0) sc[i] = NEG_INF;
    }
    float mx = fmaxf(fmaxf(fmaxf(sc[0], sc[1]), fmaxf(sc[2], sc[3])), fmaxf(fmaxf(sc[4], sc[5]), fmaxf(sc[6], sc[7])));
    mx = xmax32(xmax16(mx));
    if (__any(mx > m + 8.f)) {
        const float mn = fmaxf(m, mx), alpha = ex2(m - mn);
        m = mn; l *= alpha;
#pragma unroll
        for (int db = 0; db < 4; ++db) O[db] = O[db] * alpha;
    }
    float sum = 0.f;
#pragma unroll
    for (int i = 0; i < 8; ++i) { sc[i] = ex2(sc[i] - m); sum += sc[i]; }
    l += sum;
    u32x4 w; w.x = cvtpk(sc[0], sc[1]); w.y = cvtpk(sc[2], sc[3]); w.z = cvtpk(sc[4], sc[5]); w.w = cvtpk(sc[6], sc[7]);
    const bf16x8 pf = __builtin_bit_cast(bf16x8, w);
    const int q = (lane & 15) >> 2, pp = lane & 3, sw = (q4 & 1) << 1;
    const LAS char* base = vt + (8 * q4 + q) * 64 + (pp & 1) * 8;
#pragma unroll
    for (int db = 0; db < 4; ++db) {
        const int ch = 2 * (db & 1) + (pp >> 1);
        const LAS char* pa = base + (db >> 1) * 2048 + ((ch ^ sw) << 4);
        const s16x4 lo = trrd(pa), hi = trrd(pa + 4 * 64);
        const bf16x8 vf = {lo[0], lo[1], lo[2], lo[3], hi[0], hi[1], hi[2], hi[3]};
        O[db] = __builtin_amdgcn_mfma_f32_16x16x32_bf16(vf, pf, O[db], 0, 0, 0);
    }
}
__device__ __forceinline__ void dil_unit(const bf16* P, bf16* MX, int h, int T0, int r, LAS char* vt, const LAS float* tabR, const float* gain, int lane) {
    const int n = lane & 15, q4 = lane >> 4, tq = T0 + 16 * n + r;
    const __amdgpu_buffer_rsrc_t rs = __builtin_amdgcn_make_buffer_rsrc((void*)P, 0, SEQ * INP * 2, 0x00020000);
    const int colQ = (O_AQ + h * 64 + 8 * q4) * 2;
    const bf16x8 qf0 = __builtin_bit_cast(bf16x8, __builtin_amdgcn_raw_buffer_load_b128(rs, tq * (INP * 2) + colQ, 0, 0)), qf1 = __builtin_bit_cast(bf16x8, __builtin_amdgcn_raw_buffer_load_b128(rs, tq * (INP * 2) + colQ + 64, 0, 0));
    int kkK[2], kkV[4];
#pragma unroll
    for (int a = 0; a < 2; ++a) kkK[a] = 8 * (n >> 2) + 4 * a + (n & 3);
#pragma unroll
    for (int e = 0; e < 4; ++e) kkV[e] = 8 * e + (lane >> 3);
    const int colK = (O_AK + h * 64 + 8 * q4) * 2, colV = (O_AV + h * 64 + 8 * (lane & 7)) * 2;
    f32x4 O[4];
#pragma unroll
    for (int db = 0; db < 4; ++db) O[db] = (f32x4){0.f, 0.f, 0.f, 0.f};
    float m = NEG_INF, l = 0.f;
    const int n3 = (T0 >> 9) + 1, s2s = (T0 == 0) ? 3 : ((T0 == 256) ? 1 : 0), n2 = 6 - s2s, s1s = (T0 == 0) ? 4 : 0, ns = n3 + n2 + 12 - s1s;
    bf16x8 kfA[2][2], kfB[2][2]; u32x4 vrA[4], vrB[4];
    int kbA, shA, pA, kbB = 0, shB = 0, pB = 0;
    dil_params(0, n3, n2, s2s, s1s, T0, r, kbA, shA, pA); dil_load(kfA, vrA, rs, kkK, colK, kkV, colV, kbA, shA);
    for (int si = 0; si < ns; si += 2) {
        dil_params(si + 1 < ns ? si + 1 : ns - 1, n3, n2, s2s, s1s, T0, r, kbB, shB, pB); dil_load(kfB, vrB, rs, kkK, colK, kkV, colV, kbB, shB);
        dil_step(kfA, vrA, qf0, qf1, O, m, l, vt, tabR, kbA, shA, pA, tq, lane);
        dil_params(si + 2 < ns ? si + 2 : ns - 1, n3, n2, s2s, s1s, T0, r, kbA, shA, pA); dil_load(kfA, vrA, rs, kkK, colK, kkV, colV, kbA, shA);
        if (si + 1 < ns) dil_step(kfB, vrB, qf0, qf1, O, m, l, vt, tabR, kbB, shB, pB, tq, lane);
    }
    const float lt = xsum32(xsum16(l));
    const float inv = 1.f / lt; float ss = 0.f;
#pragma unroll
    for (int db = 0; db < 4; ++db) { O[db] = O[db] * inv; ss += (O[db][0] * O[db][0] + O[db][1] * O[db][1]) + (O[db][2] * O[db][2] + O[db][3] * O[db][3]); }
    ss = xsum32(xsum16(ss));
    const float rs_ = rsqrtf(ss * (1.f / 64.f) + EPS);
#pragma unroll
    for (int db = 0; db < 4; ++db) { const int d0 = 16 * db + 4 * q4; const f32x4 gn = *(const f32x4*)(gain + d0);
        u32x2 w; w.x = cvtpk(O[db][0] * rs_ * gn[0], O[db][1] * rs_ * gn[1]); w.y = cvtpk(O[db][2] * rs_ * gn[2], O[db][3] * rs_ * gn[3]);
        *(u32x2*)(MX + (size_t)tq * D + h * 64 + d0) = w; }
}

constexpr size_t MiB = 1u << 20;
constexpr size_t WS_CTL = 0, CTL_ZERO_BYTES = 1 * MiB;
constexpr size_t WS_MOD = 1 * MiB, WS_MODP = 2 * MiB, WS_ROPE = 9 * MiB, WS_SSP = 11 * MiB;
constexpr size_t WS_WIN = 12 * MiB, WS_WOUT = 34 * MiB, WS_WGU = 42 * MiB, WS_WDN = 86 * MiB, WS_WUP = 108 * MiB;
constexpr size_t WS_XN = 112 * MiB, WS_MIX = 144 * MiB, WS_UPO = 176 * MiB, WS_PROJ = 208 * MiB, WS_GT = 296 * MiB, WS_END = 304 * MiB;
constexpr int CW_BAR = 4096;
constexpr int RING_BYTES = 131072, LDSCTL_OFF = RING_BYTES, MISC_OFF = LDSCTL_OFF + 320, PTAB_OFF = LDSCTL_OFF + 512, TAB_OFF = LDSCTL_OFF + 768, LDS_BYTES = TAB_OFF + 6 * 3 * 132 * 4 + 64;
static_assert(LDS_BYTES <= 160 * 1024, "LDS");
constexpr int NWAVES = 8;
constexpr int NSTEPS = 3 + 8 * DEPTH;

#define XB_TMO      128
#define XB_XCNT(j)  (256  + 64 * (j))
#define XB_XSUB(j)  (1280 + 64 * (j))
#define XB_XGEN(j)  (2304 + 64 * (j))
#define XB_TOP      3328
#define XB_TOPGEN   3392
#define XCD_BAR_WORDS 3456
#define XB_SPIN_CAP (1u << 18)
typedef GAS unsigned gu32;
__device__ __forceinline__ unsigned xb_ld(gu32* p)              { return __hip_atomic_load(p, __ATOMIC_RELAXED, __HIP_MEMORY_SCOPE_AGENT); }
__device__ __forceinline__ unsigned xb_add(gu32* p, unsigned v) { return __hip_atomic_fetch_add(p, v, __ATOMIC_RELAXED, __HIP_MEMORY_SCOPE_AGENT); }
__device__ __forceinline__ unsigned xb_xcc_id() { return (unsigned)__builtin_amdgcn_s_getreg((3 << 11) | 20) & 0xFu; }
#define XB_SPIN(cond, bar) do { unsigned _sp = 0; while (cond) { __builtin_amdgcn_s_sleep(1); \
    if ((++_sp & 255u) == 0u) { if (xb_ld(&(bar)[XB_TMO])) break; if (_sp > XB_SPIN_CAP) { xb_add(&(bar)[XB_TMO], 1u); break; } } } } while (0)
struct XcdBarrier { unsigned x; volatile LAS unsigned* st; };
__device__ __forceinline__ XcdBarrier xcd_barrier_post(gu32* bar, volatile LAS unsigned* st, bool t0) {
    XcdBarrier b; b.x = xb_xcc_id(); b.st = st;
    if (t0) (void)xb_add(&bar[XB_XCNT(b.x)], 1u);
    return b;
}
__device__ __forceinline__ void xcd_barrier_complete(gu32* bar, unsigned x, unsigned& nloc, unsigned& nx) {
    const unsigned G = gridDim.x * gridDim.y * gridDim.z;
    unsigned sum, cnt, mine, sp = 0u;
    for (;;) {
        sum = 0u; cnt = 0u; mine = 0u;
#pragma unroll
        for (unsigned j = 0; j < 16; ++j) { const unsigned c = xb_ld(&bar[XB_XCNT(j)]); sum += c; cnt += (c > 0u) ? 1u : 0u; mine = (j == x) ? c : mine; }
        if (sum == G) break;
        __builtin_amdgcn_s_sleep(1);
        if ((++sp & 255u) == 0u) { if (xb_ld(&bar[XB_TMO])) break; if (sp > XB_SPIN_CAP) { xb_add(&bar[XB_TMO], 1u); break; } }
    }
    nloc = mine > 0u ? mine : 1u; nx = cnt > 0u ? cnt : 1u;
}
__device__ __forceinline__ void xcd_barrier(const XcdBarrier& b, gu32* bar_, int wave) {
    asm volatile("s_waitcnt vmcnt(0)" ::: "memory");
    __syncthreads();
    if (wave == 0 && FRESH_LANE() == 0) {
        unsigned long long bv_ = (unsigned long long)bar_; asm volatile("" : "+v"(bv_)); gu32* bar = (gu32*)bv_;
        __builtin_amdgcn_s_waitcnt(0);
        unsigned nloc = b.st[0], nx = b.st[1];
        if (nloc == 0u) { xcd_barrier_complete(bar, b.x, nloc, nx); b.st[0] = nloc; b.st[1] = nx; }
        const unsigned old = xb_add(&bar[XB_XSUB(b.x)], 1u);
        const unsigned gen = old / nloc;
        if (old + 1u == (gen + 1u) * nloc) {
            __builtin_amdgcn_fence(__ATOMIC_RELEASE, "agent");
            asm volatile("s_waitcnt vmcnt(0)" ::: "memory");
            const unsigned og = xb_add(&bar[XB_TOP], 1u);
            const unsigned tg = og / nx;
            if (og + 1u == (tg + 1u) * nx) xb_add(&bar[XB_TOPGEN], 1u);
            else XB_SPIN(xb_ld(&bar[XB_TOPGEN]) == tg, bar);
            __builtin_amdgcn_fence(__ATOMIC_ACQUIRE, "agent");
            xb_add(&bar[XB_XGEN(b.x)], 1u);
            asm volatile("s_waitcnt vmcnt(0)" ::: "memory");
        } else {
            XB_SPIN(xb_ld(&bar[XB_XGEN(b.x)]) == gen, bar);
            __builtin_amdgcn_fence(__ATOMIC_ACQUIRE, "agent");
            asm volatile("s_waitcnt vmcnt(0)" ::: "memory");
        }
    }
    __syncthreads();
}

__device__ __forceinline__ void transpose_item(const float* W, int K, int N, bf16* WT, int k0, int n0, int orow0, LAS float* scr, int lane) {
#pragma unroll 8
    for (int i = 0; i < 32; ++i) { const int kk = 2 * i + (lane >> 5); scr[kk * 33 + (lane & 31)] = W[(size_t)(k0 + kk) * N + n0 + (lane & 31)]; }
    asm volatile("s_waitcnt lgkmcnt(0)" ::: "memory");
    const int c = lane & 7;
#pragma unroll
    for (int j = 0; j < 4; ++j) { const int n = (lane >> 3) + 8 * j; const LAS float* s = scr + (8 * c) * 33 + n;
        u32x4 o; o.x = cvtpk(s[0 * 33], s[1 * 33]); o.y = cvtpk(s[2 * 33], s[3 * 33]); o.z = cvtpk(s[4 * 33], s[5 * 33]); o.w = cvtpk(s[6 * 33], s[7 * 33]);
        *(u32x4*)(WT + (size_t)(orow0 + n) * K + k0 + 8 * c) = o; }
    asm volatile("s_waitcnt lgkmcnt(0)" ::: "memory");
}
__device__ __forceinline__ void ln_rows(int gw, int ngw, int lane, const float* xin, const float* g, const float* modl, int ch_sh, int ch_sc, bf16* xn, float* outf) {
    for (int m = gw; m < M; m += ngw) {
        const f32x4* xr = (const f32x4*)(xin + (size_t)m * D) + lane;
        f32x4 v[4]; float s = 0.f;
#pragma unroll
        for (int j = 0; j < 4; ++j) { v[j] = xr[64 * j]; s += (v[j][0] * v[j][0] + v[j][1] * v[j][1]) + (v[j][2] * v[j][2] + v[j][3] * v[j][3]); }
        const float rs = rsqrtf(wave_sum(s) * (1.f / D) + EPS);
        const int b = m / SEQ;
#pragma unroll
        for (int j = 0; j < 4; ++j) { const int n0 = 4 * lane + 256 * j; f32x4 y = v[j] * rs * *(const f32x4*)(g + n0);
            if (modl) { const f32x4 sc = *(const f32x4*)(modl + (size_t)b * MODW + ch_sc * D + n0), sh = *(const f32x4*)(modl + (size_t)b * MODW + ch_sh * D + n0); y = y * (sc + 1.f) + sh; }
            if (xn) { u32x2 w; w.x = cvtpk(y[0], y[1]); w.y = cvtpk(y[2], y[3]); *(u32x2*)(xn + (size_t)m * D + n0) = w; }
            else *(f32x4*)(outf + (size_t)m * D + n0) = y; }
    }
}

struct Args { const float* in[19]; float* out; unsigned char* ws; int st_lo, st_hi; };
__global__ void __launch_bounds__(NWAVES * 64, 2) fwd(Args args) {
    extern __shared__ __attribute__((aligned(16))) unsigned char lds_raw[];
    LAS unsigned char* lds = (LAS unsigned char*)lds_raw;
    volatile LAS unsigned* MISC = (volatile LAS unsigned*)(lds + MISC_OFF);
    const int wave = __builtin_amdgcn_readfirstlane(threadIdx.x >> 6);
    const int G = gridDim.x; const int bx = blockIdx.x; const int vcu = (G % 8 == 0) ? (bx % 8) * (G / 8) + bx / 8 : bx;
    const int gw = vcu * NWAVES + wave, ngw = G * NWAVES, ngt = ngw * 64;
    LAS unsigned long long* ptab = (LAS unsigned long long*)(lds + PTAB_OFF);
    const int tid = wave * 64 + FRESH_LANE();
    if (tid == 0) {
#pragma unroll
        for (int i = 0; i < 19; ++i) ptab[i] = (unsigned long long)args.in[i];
        ptab[19] = (unsigned long long)args.out; ptab[20] = (unsigned long long)args.ws;
    }
#define FRESH_TID() (wave * 64 + FRESH_LANE())
#define FRESH_S(x) ({ int s_ = (x); asm volatile("" : "+s"(s_)); s_; })
#define LDP_RAW(i) ({ const unsigned long long v_ = ptab[i]; const unsigned lo_ = __builtin_amdgcn_readfirstlane((unsigned)v_), hi_ = __builtin_amdgcn_readfirstlane((unsigned)(v_ >> 32)); ((unsigned long long)hi_ << 32) | lo_; })
#define LDF(i) ((const float*)(const GAS float*)LDP_RAW(i))
#define LDWS(off) ((unsigned char*)(GAS unsigned char*)(LDP_RAW(20) + (off)))
#define LDOUT() ((float*)(GAS float*)LDP_RAW(19))
    for (int u = tid; u < (PTAB_OFF - LDSCTL_OFF) / 4; u += NWAVES * 64) ((LAS unsigned*)(lds + LDSCTL_OFF))[u] = 0u;
    LAS float* tab = (LAS float*)(lds + TAB_OFF);
    { const float* rel_bias = args.in[3];
      for (int u = tid; u < 6 * 3 * 129; u += NWAVES * 64) { const int j = u % 129, hp = u / 129, p = hp % 3, h = hp / 3; tab[hp * 132 + j] = rel_bias[BUCKET[p][j] * 6 + h] * LOG2E; } }
    __syncthreads();
    const int lo = args.st_lo, hi = args.st_hi;
    const XcdBarrier bar = xcd_barrier_post((gu32*)(args.ws + WS_CTL) + CW_BAR, MISC + 8, tid == 0);
#ifndef PHASE_MASK
#define PHASE_MASK 0xffff
#endif
#ifndef DUP_RET
#define DUP_RET 1
#endif
#ifndef DUP_DIL
#define DUP_DIL 1
#endif
#ifndef DUP_MLA
#define DUP_MLA 1
#endif
#ifndef DUP_INPROJ
#define DUP_INPROJ 1
#endif
#ifndef DUP_GU
#define DUP_GU 1
#endif
#ifndef DUP_LN2
#define DUP_LN2 1
#endif
#ifndef DUP_P1
#define DUP_P1 1
#endif
#ifndef DUP_P0
#define DUP_P0 1
#endif
#ifndef DUP_P2
#define DUP_P2 1
#endif
#define PHM(b) ((PHASE_MASK >> (b)) & 1)
#define IN(k) (lo <= (k) && (k) < hi)
#define SEAM(k) do { if (IN(k) && IN((k) + 1)) xcd_barrier(bar, (gu32*)(args.ws + WS_CTL) + CW_BAR, wave); } while (0)

    if (PHM(0) && IN(0)) _Pragma("unroll 1") for (int prep = 0; prep < DUP_P0; ++prep) {
        if (prep) { asm volatile("s_waitcnt vmcnt(0) lgkmcnt(0)" ::: "memory"); __syncthreads(); }
        const int tidp = FRESH_TID(), lane = tidp & 63, gt = gw * 64 + lane;
        const float* c_in = LDF(1); const int* pos = (const int*)LDF(2); const float* ada_w = LDF(4); const float* w_in = LDF(7);
        const float* q_norm = LDF(8); const float* kv_norm = LDF(9); const float* w_uq = LDF(10); const float* w_ukv = LDF(11);
        const float* w_out = LDF(13); const float* w_gate = LDF(15); const float* w_up = LDF(16); const float* w_down = LDF(17);
        float* modp = (float*)LDWS(WS_MODP); float* ropec = (float*)LDWS(WS_ROPE); float* ropes = ropec + (size_t)M * 16;
        bf16* Win_t = (bf16*)LDWS(WS_WIN); bf16* Wout_t = (bf16*)LDWS(WS_WOUT); bf16* Wgu_t = (bf16*)LDWS(WS_WGU); bf16* Wdn_t = (bf16*)LDWS(WS_WDN); bf16* Wup_t = (bf16*)LDWS(WS_WUP);
        LAS float* scr = (LAS float*)(lds + wave * 8704);
        LAS float* cact = (LAS float*)(lds + 73728);
        for (int i = tidp; i < BATCH * D; i += NWAVES * 64) { const int b = i / D, k = i % D; const float v = c_in[i]; cact[k * 8 + b] = v / (1.f + expf(-v)); }
        __syncthreads();
        for (int it = gw; it < DEPTH * 96 * 8; it += ngw) {
            const int kq = it & 7, cg = (it >> 3) % 96, l = it / (96 * 8), n = cg * 64 + lane;
            const float* wp = ada_w + ((size_t)l * D + kq * 128) * MODW + n;
            float a[8];
#pragma unroll
            for (int b = 0; b < 8; ++b) a[b] = 0.f;
#pragma unroll 16
            for (int k = 0; k < 128; ++k) { const float wv = wp[(size_t)k * MODW]; const f32x4 c0 = *(const LAS f32x4*)(cact + (kq * 128 + k) * 8), c1 = *(const LAS f32x4*)(cact + (kq * 128 + k) * 8 + 4);
                a[0] += c0[0] * wv; a[1] += c0[1] * wv; a[2] += c0[2] * wv; a[3] += c0[3] * wv; a[4] += c1[0] * wv; a[5] += c1[1] * wv; a[6] += c1[2] * wv; a[7] += c1[3] * wv; }
#pragma unroll
            for (int b = 0; b < 8; ++b) modp[(((size_t)kq * DEPTH + l) * BATCH + b) * MODW + n] = a[b];
        }
        constexpr int I_IN = 16 * 85, I_OUT = 16 * 32, I_G = 16 * 88, I_DN = 44 * 32, I_L = I_IN + I_OUT + 2 * I_G + I_DN;
        for (int it = gw; it < DEPTH * I_L; it += ngw) {
            const int l = it / I_L; int r = it % I_L;
            if (r < I_IN) { const int kb = r / 85, nb = r % 85; transpose_item(w_in + (size_t)l * D * INW, D, INW, Win_t + (size_t)l * INP * D, 64 * kb, 32 * nb, 32 * nb, scr, lane); continue; } r -= I_IN;
            if (r < I_OUT) { const int kb = r / 32, nb = r % 32; transpose_item(w_out + (size_t)l * D * D, D, D, Wout_t + (size_t)l * D * D, 64 * kb, 32 * nb, 32 * nb, scr, lane); continue; } r -= I_OUT;
            if (r < I_G) { const int kb = r / 88, nb = r % 88, n0 = 32 * nb; transpose_item(w_gate + (size_t)l * D * FFH, D, FFH, Wgu_t + (size_t)l * GU * D, 64 * kb, n0, 256 * (n0 >> 7) + (n0 & 127), scr, lane); continue; } r -= I_G;
            if (r < I_G) { const int kb = r / 88, nb = r % 88, n0 = 32 * nb; transpose_item(w_up + (size_t)l * D * FFH, D, FFH, Wgu_t + (size_t)l * GU * D, 64 * kb, n0, 256 * (n0 >> 7) + 128 + (n0 & 127), scr, lane); continue; } r -= I_G;
            { const int kb = r / 32, nb = r % 32; transpose_item(w_down + (size_t)l * FFH * D, FFH, D, Wdn_t + (size_t)l * D * FFH, 64 * kb, 32 * nb, 32 * nb, scr, lane); }
        }
        for (int i = gt; i < DEPTH * 96 * D / 8; i += ngt) { const int l = i / (96 * D / 8), r = i % (96 * D / 8); *(u32x4*)(Win_t + (size_t)l * INP * D + (size_t)INW * D + (size_t)r * 8) = (u32x4){0u, 0u, 0u, 0u}; }
        for (int i = gt; i < DEPTH * UPN * UPK; i += ngt) { const int l = i / (UPN * UPK), rr = i % (UPN * UPK), n = rr / UPK, k = rr % UPK; float v = 0.f;
            if (n < 384) { if (k < 256) v = q_norm[l * 256 + k] * w_uq[((size_t)l * 256 + k) * 384 + n]; }
            else if (n < 896) { if (k >= 256) v = kv_norm[l * 128 + (k - 256)] * w_ukv[((size_t)l * 128 + (k - 256)) * 512 + (n - 384)]; }
            Wup_t[i] = (bf16)(cvtpk(v, 0.f) & 0xffffu); }
        for (int i = gt; i < M * 16; i += ngt) { const int m = i >> 4, f = i & 15; const float ang = (float)pos[m] * INV_FREQ[f]; ropec[i] = cosf(ang); ropes[i] = sinf(ang); }
    }
    SEAM(0);
    if (PHM(1) && IN(1)) {
        const int gt = gw * 64 + (FRESH_TID() & 63);
        const float* ada_b = LDF(5); const float* modp = (const float*)LDWS(WS_MODP); float* mod = (float*)LDWS(WS_MOD);
        for (int i = gt; i < DEPTH * BATCH * MODW; i += ngt) { const int n = i % MODW, l = i / (BATCH * MODW); float s = 0.f;
#pragma unroll
            for (int kq = 0; kq < 8; ++kq) s += modp[(size_t)kq * DEPTH * BATCH * MODW + i];
            mod[i] = s + ada_b[l * MODW + n]; }
    }
    SEAM(1);
    if (PHM(2) && IN(2)) ln_rows(FRESH_S(gw), ngw, FRESH_LANE(), LDF(0), LDF(6), (const float*)LDWS(WS_MOD), 0, 1, (bf16*)LDWS(WS_XN), nullptr);
    SEAM(2);

#pragma unroll 1
    for (int l = 0; l < DEPTH; ++l) {
        const int sb = 3 + 8 * l;
        if (PHM(3) && IN(sb + 0)) {
            float* ropec = (float*)LDWS(WS_ROPE);
            pg8::Gemm g{(const bf16*)LDWS(WS_XN), (const bf16*)LDWS(WS_WIN) + (size_t)l * INP * D}; pg8::StaticOrder<INP> S; S.init(G, FRESH_S(bx));
            pg8::EpiInProj E{(bf16*)LDWS(WS_PROJ), (float*)LDWS(WS_SSP), ropec, ropec + (size_t)M * 16};
            _Pragma("unroll 1") for (int rep = 0; rep < DUP_INPROJ; ++rep)
            pg8::gemm_phase<pg8::EpiInProj, pg8::StaticOrder<INP>, true, D, D>(lds, g, S, E, wave);
        }
        SEAM(sb + 0);
        if (PHM(4) && IN(sb + 1)) _Pragma("unroll 1") for (int prep = 0; prep < DUP_P1; ++prep) {
            if (prep) { asm volatile("s_waitcnt vmcnt(0) lgkmcnt(0)" ::: "memory"); __syncthreads(); }
            { float* ropec = (float*)LDWS(WS_ROPE);
              pg8::Gemm g{(const bf16*)LDWS(WS_PROJ) + O_BQ, (const bf16*)LDWS(WS_WUP) + (size_t)l * UPN * UPK}; pg8::StaticOrder<UPN> S; S.init(G, FRESH_S(bx));
              pg8::EpiUp E{(bf16*)LDWS(WS_UPO), (const float*)LDWS(WS_SSP), ropec, ropec + (size_t)M * 16};
              pg8::gemm_phase<pg8::EpiUp, pg8::StaticOrder<UPN>, true, UPK, INP>(lds, g, S, E, wave); }
            const int lane = FRESH_LANE(), gwp = FRESH_S(gw);
            LAS char* vt = (LAS char*)(lds + FRESH_S(wave) * 4096);
            const bf16* PROJ = (const bf16*)LDWS(WS_PROJ); bf16* MIX = (bf16*)LDWS(WS_MIX); const float* mix_gain = LDF(12) + l * D;
            { float* GT = (float*)LDWS(WS_GT); LAS char* kt = (LAS char*)(lds + 32768 + FRESH_S(wave) * 2048);
              _Pragma("unroll 1") for (int rep = 0; rep < DUP_RET; ++rep)
              for (int u = gwp; u < 48 * 16; u += ngw) { const int bh = u >> 4, n = u & 15, b = bh / 6, h = bh % 6;
                  ret_pass1(PROJ + (size_t)b * SEQ * INP, h, n, GT + (size_t)u * 2048, kt, vt, lane); } }
            { LAS float* tr_ = (LAS float*)(lds + 81920); const int t = FRESH_S(wave) * 64 + lane;
              for (int i = t; i < 18 * 640; i += NWAVES * 64) { const int hp = i / 640, j = 383 - (i % 640); tr_[i] = ((unsigned)j <= 128u) ? tab[hp * 132 + j] : NEG_INF; }
              asm volatile("s_waitcnt lgkmcnt(0)" ::: "memory"); __syncthreads(); }
            _Pragma("unroll 1") for (int rep = 0; rep < DUP_DIL; ++rep)
            for (int u = gwp; u < 6144; u += ngw) {
                const int r = u & 15, qb = (u >> 4) & 7, bh = u >> 7, b = bh / 6, h = bh % 6;
                dil_unit(PROJ + (size_t)b * SEQ * INP, MIX + (size_t)b * SEQ * D, h, qb * 256, r, vt, (const LAS float*)(lds + 81920) + h * 3 * 640, mix_gain + h * 64, lane);
            }
        }
        SEAM(sb + 1);
        if (PHM(5) && IN(sb + 2)) _Pragma("unroll 1") for (int prep = 0; prep < DUP_P2; ++prep) {
            if (prep) { asm volatile("s_waitcnt vmcnt(0) lgkmcnt(0)" ::: "memory"); __syncthreads(); }
            const int lane = FRESH_LANE(), gwp = FRESH_S(gw);
            LAS char* vt = (LAS char*)(lds + FRESH_S(wave) * 4096);
            const bf16* PROJ = (const bf16*)LDWS(WS_PROJ); const bf16* UPO = (const bf16*)LDWS(WS_UPO); bf16* MIX = (bf16*)LDWS(WS_MIX); const float* mix_gain = LDF(12) + l * D;
            { const float* GT = (const float*)LDWS(WS_GT); const int vc = gwp >> 3, t = FRESH_S(wave) * 64 + lane;
              f32x4 run = (f32x4){0.f, 0.f, 0.f, 0.f}; int pbh = -1, pn = 0;
              for (int i = 0; i < 3; ++i) { const int g = 3 * vc + i; if (g >= 768) break; const int bh = g >> 4, n = g & 15;
                  if (bh != pbh) { run = (f32x4){0.f, 0.f, 0.f, 0.f}; pn = 0; pbh = bh; }
                  const float* gp = GT + (size_t)bh * 16 * 2048 + 4 * t;
                  f32x4 a0 = run, a1 = (f32x4){0.f, 0.f, 0.f, 0.f}, a2 = a1, a3 = a1;
                  int mc = pn;
                  for (; mc + 4 <= n; mc += 4) { a0 += *(const f32x4*)(gp + (size_t)mc * 2048); a1 += *(const f32x4*)(gp + (size_t)(mc + 1) * 2048); a2 += *(const f32x4*)(gp + (size_t)(mc + 2) * 2048); a3 += *(const f32x4*)(gp + (size_t)(mc + 3) * 2048); }
                  for (; mc < n; ++mc) a0 += *(const f32x4*)(gp + (size_t)mc * 2048);
                  run = (a0 + a1) + (a2 + a3); pn = n;
                  u32x2 w; w.x = cvtpk(run[0], run[1]); w.y = cvtpk(run[2], run[3]);
                  *(LAS u32x2*)(lds + 65536 + i * 5120 + (t >> 3) * 80 + (t & 7) * 8) = w; }
              asm volatile("s_waitcnt lgkmcnt(0)" ::: "memory"); __syncthreads(); }
            _Pragma("unroll 1") for (int rep = 0; rep < DUP_MLA; ++rep)
            for (int u = gwp; u < 32 * 64; u += ngw) {
                const int bh = u >> 6, i64 = u & 63, c8 = i64 >> 3, w = i64 & 7, blk = (w < 4) ? c8 * 4 + w : 63 - (c8 * 4 + (w - 4));
                const int b = bh >> 2, h = bh & 3; const bf16* Ub = UPO + (size_t)b * SEQ * UPN;
                FaSrc S{Ub + h * 96, UPN, Ub + 384 + h * 128, UPN, PROJ + (size_t)b * SEQ * INP + O_BKR, INP, Ub + 384 + h * 128 + 64, UPN};
                fa_unit<6, 4, 0>(S, blk * 32, vt, MIX + (size_t)b * SEQ * D + 384 + h * 64, mix_gain + 384 + h * 64, nullptr, lane);
            }
            _Pragma("unroll 1") for (int rep = 0; rep < DUP_RET; ++rep)
            if ((gwp & 7) < 4) { const int vc = gwp >> 3;
              for (int i = 0; i < 3; ++i) { const int g = 3 * vc + i; if (g >= 768) break;
                const int bh = g >> 4, n = g & 15, j = gwp & 3, b = bh / 6, h = bh % 6; const bf16* Pb = PROJ + (size_t)b * SEQ * INP;
                FaSrc S{Pb + O_CQ + h * 32, INP, Pb + O_CK + h * 32, INP, nullptr, 0, Pb + O_CV + h * 64, INP};
                ret_pass2(S, n, j, (const LAS char*)(lds + 65536 + i * 5120), vt, MIX + (size_t)b * SEQ * D + 640 + h * 64, mix_gain + 640 + h * 64, Pb + O_CG + h * 64, lane); } }
        }
        SEAM(sb + 2);
        if (PHM(6) && IN(sb + 3)) {
            float* out = LDOUT(); const float* x_in = LDF(0);
            pg8::Gemm g{(const bf16*)LDWS(WS_MIX), (const bf16*)LDWS(WS_WOUT) + (size_t)l * D * D}; pg8::StaticOrder<D> S; S.init(G, FRESH_S(bx));
            pg8::EpiRes E{l == 0 ? x_in : (const float*)out, out, (const float*)LDWS(WS_MOD) + (size_t)l * BATCH * MODW + 2 * D};
            pg8::gemm_phase<pg8::EpiRes, pg8::StaticOrder<D>, true, D, D>(lds, g, S, E, wave);
        }
        SEAM(sb + 3);
        if (PHM(7) && IN(sb + 4)) _Pragma("unroll 1") for (int rep = 0; rep < DUP_LN2; ++rep) ln_rows(FRESH_S(gw), ngw, FRESH_LANE(), LDOUT(), LDF(14) + l * D, (const float*)LDWS(WS_MOD) + (size_t)l * BATCH * MODW, 3, 4, (bf16*)LDWS(WS_XN), nullptr);
        SEAM(sb + 4);
        if (PHM(8) && IN(sb + 5)) {
            pg8::Gemm g{(const bf16*)LDWS(WS_XN), (const bf16*)LDWS(WS_WGU) + (size_t)l * GU * D}; pg8::StaticOrder<GU> S; S.init(G, FRESH_S(bx));
            pg8::EpiSwiGLU E{(bf16*)LDWS(WS_PROJ)};
            _Pragma("unroll 1") for (int rep = 0; rep < DUP_GU; ++rep)
            pg8::gemm_phase<pg8::EpiSwiGLU, pg8::StaticOrder<GU>, true, D, D>(lds, g, S, E, wave);
        }
        SEAM(sb + 5);
        if (PHM(9) && IN(sb + 6)) {
            float* out = LDOUT();
            pg8::Gemm g{(const bf16*)LDWS(WS_PROJ), (const bf16*)LDWS(WS_WDN) + (size_t)l * D * FFH}; pg8::StaticOrder<D> S; S.init(G, FRESH_S(bx));
            pg8::EpiRes E{out, out, (const float*)LDWS(WS_MOD) + (size_t)l * BATCH * MODW + 5 * D};
            pg8::gemm_phase<pg8::EpiRes, pg8::StaticOrder<D>, true, FFH, FFH>(lds, g, S, E, wave);
        }
        SEAM(sb + 6);
        if (PHM(10) && IN(sb + 7)) {
            const int lane = FRESH_LANE(), gwp = FRESH_S(gw);
            float* out = LDOUT();
            if (l + 1 < DEPTH) ln_rows(gwp, ngw, lane, out, LDF(6) + (l + 1) * D, (const float*)LDWS(WS_MOD) + (size_t)(l + 1) * BATCH * MODW, 0, 1, (bf16*)LDWS(WS_XN), nullptr);
            else ln_rows(gwp, ngw, lane, out, LDF(18), nullptr, 0, 0, nullptr, out);
        }
        if (sb + 8 < NSTEPS) SEAM(sb + 7);
    }
#undef IN
#undef SEAM
}

extern "C" void kernel_launch(void* const* d_in, const int* in_sizes, int n_in, void* d_out, int out_size, void* d_ws, size_t ws_size, hipStream_t stream) {
    static int grid = 0;
    if (grid == 0) {
        if (n_in != 19 || out_size != M * D || ws_size < WS_END) { fprintf(stderr, "kernel_launch: unexpected shapes (n_in %d out %d ws %zu need %zu)\n", n_in, out_size, ws_size, (size_t)WS_END); grid = -1; return; }
        int dev = 0, cus = 0, per_cu = 0;
        if (hipGetDevice(&dev) != hipSuccess || hipDeviceGetAttribute(&cus, hipDeviceAttributeMultiprocessorCount, dev) != hipSuccess) { grid = -1; return; }
        if (hipFuncSetAttribute((const void*)fwd, hipFuncAttributeMaxDynamicSharedMemorySize, LDS_BYTES) != hipSuccess) { fprintf(stderr, "kernel_launch: hipFuncSetAttribute failed\n"); grid = -1; return; }
        if (hipOccupancyMaxActiveBlocksPerMultiprocessor(&per_cu, (const void*)fwd, NWAVES * 64, LDS_BYTES) != hipSuccess || per_cu < 1) fprintf(stderr, "kernel_launch: occupancy query reports %d\n", per_cu);
        (void)hipGetLastError();
        grid = cus;
    }
    if (grid < 0) return;
    if (hipMemsetAsync((char*)d_ws + WS_CTL, 0, CTL_ZERO_BYTES, stream) != hipSuccess) return;
    Args a{};
    for (int i = 0; i < 19; ++i) a.in[i] = (const float*)d_in[i];
    a.out = (float*)d_out; a.ws = (unsigned char*)d_ws;
    if (MK_N_LAUNCHES == 1) { a.st_lo = 0; a.st_hi = NSTEPS; hipLaunchKernelGGL(fwd, dim3(grid), dim3(NWAVES * 64), LDS_BYTES, stream, a); }
    else for (int s = 0; s < NSTEPS; ++s) { a.st_lo = s; a.st_hi = s + 1; hipLaunchKernelGGL(fwd, dim3(grid), dim3(NWAVES * 64), LDS_BYTES, stream, a); }
    const hipError_t le = hipPeekAtLastError();
    if (le != hipSuccess) fprintf(stderr, "kernel_launch: launch failed: %s\n", hipGetErrorName(le));
}
```
